# Optimizing an MI355X kernel written in HIP

```python
import jax, jax.numpy as jnp
from jax import lax
import numpy as np

D_MODEL = 2048
BATCH = 8
SEQ = 4096
DEPTH = 2

CTX_LEN = 256
GRID_W = 64
EPS = 1e-6
WIDTH_A = D_MODEL // 2
HEAD_DIM_A = 128
N_HEADS_A = WIDTH_A // HEAD_DIM_A
SCAN_CHUNK = 64
WIDTH_B = D_MODEL // 2
CHUNK_B = 128
N_GROUPS_B = 8
GROUP_DIM_B = WIDTH_B // N_GROUPS_B
WIDTH_C = D_MODEL
CONV_W = 3
N_EXPERT_GROUPS = 4
EXPERTS_PER_GROUP = 8
N_EXPERTS = N_EXPERT_GROUPS * EXPERTS_PER_GROUP
TOP_K = 2
EXPERT_FF = 512
DISPATCH_BLOCK = 128
N_EVEN_LAYERS = (DEPTH + 1) // 2
N_ODD_LAYERS = DEPTH // 2

kernel_name = "hgrn2_gmlp_shortconv_hmoe_diffusion_trunk"


def _rms(x, g):
    xf = x.astype(jnp.float32)
    y = xf * lax.rsqrt(jnp.mean(xf * xf, axis=-1, keepdims=True) + EPS)
    return (y * g.astype(jnp.float32)).astype(x.dtype)


def _heads(t):
    b, L, _ = t.shape
    return t.reshape(b, L, N_HEADS_A, HEAD_DIM_A).transpose(0, 2, 1, 3)


def _flip(t):
    return None if t is None else t[:, :, ::-1]


def _forget(f_raw, lb):
    f = lb + (1.0 - lb) * jax.nn.sigmoid(f_raw)
    return _heads(1.0 - f), _heads(jnp.log(f))


def _gla_scan(q, k, v, logf, s0):
    b, h, L, dk = k.shape
    dv = v.shape[-1]
    n = L // SCAN_CHUNK

    def chunks(t):
        return t.reshape(b, h, n, SCAN_CHUNK, t.shape[-1])

    k, v, logf = chunks(k), chunks(v), chunks(logf)
    cum = jnp.cumsum(logf, axis=3)
    last = cum[:, :, :, -1:, :]
    d_state = jnp.einsum('bhnsk,bhnsv->nbhkv', k * jnp.exp(last - cum), v)
    decay = jnp.moveaxis(jnp.exp(last[:, :, :, 0, :]), 2, 0)
    collect = q is not None

    def step(s, inp):
        dec, ds = inp
        return dec[..., None] * s + ds, (s if collect else None)

    s_final, s_start = lax.scan(step, s0, (decay, d_state))
    if not collect:
        return None, s_final
    q_dec = chunks(q) * jnp.exp(cum)
    scores = jnp.einsum('bhntk,bhnsk->bhnts', q_dec, k * jnp.exp(-cum))
    tri = jnp.tril(jnp.ones((SCAN_CHUNK, SCAN_CHUNK), dtype=bool))
    o = jnp.einsum('bhnts,bhnsv->bhntv', jnp.where(tri, scores, 0.0), v)
    o = o + jnp.einsum('bhntk,nbhkv->bhntv', q_dec, s_start)
    return o.reshape(b, h, L, dv), s_final


def _hgrn_out(o, g, norm_g):
    b, _, L, _ = o.shape
    o = o.transpose(0, 2, 1, 3)
    o = o * lax.rsqrt(jnp.mean(o * o, axis=-1, keepdims=True) + EPS)
    o = o * norm_g.astype(jnp.float32).reshape(N_HEADS_A, HEAD_DIM_A)
    return o.reshape(b, L, WIDTH_A) * jax.nn.silu(g)


def _chunk_gmlp(p, ln_g, ln_b, w_s, b_s):
    b, L, _ = p.shape
    u, v = jnp.split(jax.nn.gelu(p.astype(jnp.float32)), 2, axis=-1)
    mu = jnp.mean(v, axis=-1, keepdims=True)
    var = jnp.mean(jnp.square(v - mu), axis=-1, keepdims=True)
    v = (v - mu) * lax.rsqrt(var + EPS) * ln_g.astype(jnp.float32) + ln_b.astype(jnp.float32)
    v = v.reshape(b, L // CHUNK_B, CHUNK_B, N_GROUPS_B, GROUP_DIM_B)
    s = jnp.einsum('gts,bnsgd->bntgd', w_s.astype(jnp.float32), v)
    s = s + b_s.astype(jnp.float32).T[:, :, None]
    return u * s.reshape(b, L, WIDTH_B)


def _even_mixer(h, h_ctx, w_in, w_out, lb, a_norm_g, ln_g, ln_b, w_s, b_s, ctx_out):
    f32 = jnp.float32
    na = 5 * WIDTH_A
    proj = h @ w_in
    q, f_fw, f_bw, v, g = jnp.split(proj[..., :na].astype(f32), 5, axis=-1)
    if ctx_out:
        proj_c = h_ctx @ w_in
        cq, cf_fw, cf_bw, cv, cg = jnp.split(proj_c[..., :na].astype(f32), 5, axis=-1)
        cq = _heads(jax.nn.silu(cq))
    else:
        cf_fw, cf_bw, cv = jnp.split((h_ctx @ w_in[:, WIDTH_A:4 * WIDTH_A]).astype(f32), 3, axis=-1)
        cq = None
    s0 = jnp.zeros((h.shape[0], N_HEADS_A, HEAD_DIM_A, HEAD_DIM_A), f32)
    k_cf, lf_cf = _forget(cf_fw, lb[0])
    k_cb, lf_cb = _forget(cf_bw, lb[1])
    cvh = _heads(cv)
    oc_f, st_f = _gla_scan(cq, k_cf, cvh, lf_cf, s0)
    oc_b, st_b = _gla_scan(_flip(cq), _flip(k_cb), _flip(cvh), _flip(lf_cb), s0)
    qh = _heads(jax.nn.silu(q))
    vh = _heads(v)
    k_f, lf_f = _forget(f_fw, lb[0])
    k_b, lf_b = _forget(f_bw, lb[1])
    o_f, _ = _gla_scan(qh, k_f, vh, lf_f, st_f)
    o_b, _ = _gla_scan(_flip(qh), _flip(k_b), _flip(vh), _flip(lf_b), st_b)
    a = _hgrn_out(o_f + _flip(o_b), g, a_norm_g)
    bm = _chunk_gmlp(proj[..., na:], ln_g, ln_b, w_s, b_s)
    y = jnp.concatenate([a, bm], axis=-1).astype(h.dtype) @ w_out
    y_ctx = None
    if ctx_out:
        ac = _hgrn_out(oc_f + _flip(oc_b), cg, a_norm_g)
        bc = _chunk_gmlp(proj_c[..., na:], ln_g, ln_b, w_s, b_s)
        y_ctx = jnp.concatenate([ac, bc], axis=-1).astype(h.dtype) @ w_out
    return y, y_ctx


def _short_conv(z, w, rows):
    b, L, ch = z.shape
    if rows is not None:
        z = z.reshape(b, rows, GRID_W, ch)
    n = z.shape[-2]
    half = CONV_W // 2
    pad = [(0, 0)] * (z.ndim - 2) + [(half, half), (0, 0)]
    zp = jnp.pad(z, pad)
    y = sum(zp[..., k:k + n, :] * w[k] for k in range(CONV_W))
    return y.reshape(b, L, ch)


def _gated_short_conv(h, w_in, conv_w, w_out, rows):
    hx, bg, cg = jnp.split(h @ w_in, 3, axis=-1)
    return (bg * _short_conv(cg * hx, conv_w, rows)) @ w_out


def _hier_moe(t, rg_w, rg_b, re_w, re_b, w_gate, w_up, w_down):
    n_tok, d = t.shape
    f32 = jnp.float32
    p_grp = jax.nn.softmax((t @ rg_w + rg_b).astype(f32), axis=-1)
    p_top, grp = lax.top_k(p_grp, 1)
    le = (t @ re_w + re_b).astype(f32).reshape(n_tok, N_EXPERT_GROUPS, EXPERTS_PER_GROUP)
    le = jnp.einsum('tge,tg->te', le, jax.nn.one_hot(grp[:, 0], N_EXPERT_GROUPS, dtype=f32))
    p_in, idx = lax.top_k(jax.nn.softmax(le, axis=-1), TOP_K)
    wts = (p_top * p_in / jnp.sum(p_in, axis=-1, keepdims=True)).reshape(-1)
    eid = (grp * EXPERTS_PER_GROUP + idx).reshape(-1)
    tok = jnp.repeat(jnp.arange(n_tok, dtype=jnp.int32), TOP_K)
    n_assign = n_tok * TOP_K
    order = jnp.argsort(eid)
    eid_s = eid[order]
    counts = jnp.bincount(eid, length=N_EXPERTS)
    starts = jnp.cumsum(counts) - counts
    padded = (counts + DISPATCH_BLOCK - 1) // DISPATCH_BLOCK * DISPATCH_BLOCK
    pend = jnp.cumsum(padded)
    pos = (pend - padded)[eid_s] + (jnp.arange(n_assign, dtype=jnp.int32) - starts[eid_s])
    n_blk = -(-n_assign // DISPATCH_BLOCK) + N_EXPERTS
    n_rows = n_blk * DISPATCH_BLOCK
    buf_tok = jnp.full((n_rows,), n_tok, jnp.int32).at[pos].set(tok[order])
    buf_w = jnp.zeros((n_rows,), f32).at[pos].set(wts[order])
    blk_e = jnp.searchsorted(pend, jnp.arange(n_blk, dtype=jnp.int32) * DISPATCH_BLOCK, side='right')
    blk_e = jnp.minimum(blk_e, N_EXPERTS - 1)
    t_pad = jnp.concatenate([t, jnp.zeros((1, d), t.dtype)], axis=0)
    xb = t_pad[buf_tok].reshape(n_blk, DISPATCH_BLOCK, d)

    def expert_block(args):
        xblk, e = args
        return (jax.nn.silu(xblk @ w_gate[e]) * (xblk @ w_up[e])) @ w_down[e]

    yb = lax.map(expert_block, (xb, blk_e)).reshape(n_rows, d)
    out = jnp.zeros((n_tok + 1, d), t.dtype).at[buf_tok].add(yb * buf_w[:, None].astype(t.dtype))
    return out[:n_tok]


def setup_inputs(seed: int = 0) -> dict:
    key = jax.random.key(seed)
    ks = jax.random.split(key, 27)
    D = D_MODEL
    ne, no = N_EVEN_LAYERS, N_ODD_LAYERS
    pe = 5 * WIDTH_A + 2 * WIDTH_B

    def n(k, shape, s):
        return jax.random.normal(k, shape, jnp.float32) * s

    return {
        "x": n(ks[0], (BATCH, SEQ, D), 1.0),
        "c": n(ks[1], (BATCH, D), 1.0),
        "ctx": n(ks[2], (BATCH, CTX_LEN, D), 1.0),
        "c_ctx": n(ks[3], (D,), 1.0),
        "w_mod": n(ks[4], (DEPTH, D, 6 * D), 0.5 * D ** -0.5),
        "b_mod": n(ks[5], (DEPTH, 6 * D), 0.02),
        "norm_mix_g": 1.0 + n(ks[6], (DEPTH, D), 0.02),
        "norm_ffn_g": 1.0 + n(ks[7], (DEPTH, D), 0.02),
        "final_g": 1.0 + n(ks[8], (D,), 0.02),
        "even_w_in": n(ks[9], (ne, D, pe), D ** -0.5),
        "even_w_out": n(ks[10], (ne, WIDTH_A + WIDTH_B, D), (WIDTH_A + WIDTH_B) ** -0.5),
        "hgrn_lb_raw": n(ks[11], (ne + 1, 2, WIDTH_A), 0.1),
        "hgrn_norm_g": 1.0 + n(ks[12], (ne, WIDTH_A), 0.02),
        "gmlp_ln_g": 1.0 + n(ks[13], (ne, WIDTH_B), 0.02),
        "gmlp_ln_b": n(ks[14], (ne, WIDTH_B), 0.02),
        "gmlp_w_s": n(ks[15], (ne, N_GROUPS_B, CHUNK_B, CHUNK_B), CHUNK_B ** -0.5),
        "gmlp_b_s": 1.0 + n(ks[16], (ne, N_GROUPS_B, CHUNK_B), 0.02),
        "odd_w_in": n(ks[17], (no, D, 3 * WIDTH_C), D ** -0.5),
        "odd_conv_w": n(ks[18], (no, CONV_W, WIDTH_C), CONV_W ** -0.5),
        "odd_w_out": n(ks[19], (no, WIDTH_C, D), WIDTH_C ** -0.5),
        "router_g_w": n(ks[20], (DEPTH, D, N_EXPERT_GROUPS), D ** -0.5),
        "router_g_b": n(ks[21], (DEPTH, N_EXPERT_GROUPS), 0.01),
        "router_e_w": n(ks[22], (DEPTH, D, N_EXPERTS), D ** -0.5),
        "router_e_b": n(ks[23], (DEPTH, N_EXPERTS), 0.01),
        "exp_w_gate": n(ks[24], (DEPTH, N_EXPERTS, D, EXPERT_FF), D ** -0.5),
        "exp_w_up": n(ks[25], (DEPTH, N_EXPERTS, D, EXPERT_FF), D ** -0.5),
        "exp_w_down": n(ks[26], (DEPTH, N_EXPERTS, EXPERT_FF, D), EXPERT_FF ** -0.5),
    }


def reference(x, c, ctx, c_ctx, w_mod, b_mod, norm_mix_g, norm_ffn_g, final_g,
              even_w_in, even_w_out, hgrn_lb_raw, hgrn_norm_g, gmlp_ln_g, gmlp_ln_b, gmlp_w_s, gmlp_b_s,
              odd_w_in, odd_conv_w, odd_w_out,
              router_g_w, router_g_b, router_e_w, router_e_b, exp_w_gate, exp_w_up, exp_w_down):
    b, seq, d = x.shape
    rows = seq // GRID_W
    n_ctx = ctx.shape[1]
    last_ctx_layer = ((DEPTH - 1) // 2) * 2
    lb_all = jnp.cumsum(jax.nn.softmax(hgrn_lb_raw.astype(jnp.float32), axis=0), axis=0)
    silu_c = jax.nn.silu(c)
    silu_cc = jax.nn.silu(c_ctx)
    hc = ctx
    for l in range(DEPTH):
        j = l // 2
        ctx_full = l < last_ctx_layer
        mod = silu_c @ w_mod[l] + b_mod[l]
        sh_m, sc_m, gt_m, sh_f, sc_f, gt_f = jnp.split(mod[:, None, :], 6, axis=-1)
        if ctx_full:
            mod_c = silu_cc @ w_mod[l] + b_mod[l]
            csh_m, csc_m, cgt_m, csh_f, csc_f, cgt_f = jnp.split(mod_c, 6)
        elif l == last_ctx_layer:
            csh_m, csc_m = jnp.split(silu_cc @ w_mod[l][:, :2 * d] + b_mod[l][:2 * d], 2)
        h = _rms(x, norm_mix_g[l]) * (1.0 + sc_m) + sh_m
        if l % 2 == 0:
            h_ctx = _rms(hc, norm_mix_g[l]) * (1.0 + csc_m) + csh_m
            y, y_ctx = _even_mixer(h, h_ctx, even_w_in[j], even_w_out[j], lb_all[j], hgrn_norm_g[j],
                                   gmlp_ln_g[j], gmlp_ln_b[j], gmlp_w_s[j], gmlp_b_s[j], ctx_full)
        else:
            y = _gated_short_conv(h, odd_w_in[j], odd_conv_w[j], odd_w_out[j], rows)
            if ctx_full:
                h_ctx = _rms(hc, norm_mix_g[l]) * (1.0 + csc_m) + csh_m
                y_ctx = _gated_short_conv(h_ctx, odd_w_in[j], odd_conv_w[j], odd_w_out[j], None)
        x = x + gt_m * y
        if ctx_full:
            hc = hc + cgt_m * y_ctx
        h = _rms(x, norm_ffn_g[l]) * (1.0 + sc_f) + sh_f
        tokens = h.reshape(b * seq, d)
        if ctx_full:
            hcf = _rms(hc, norm_ffn_g[l]) * (1.0 + csc_f) + csh_f
            tokens = jnp.concatenate([tokens, hcf.reshape(b * n_ctx, d)], axis=0)
        f = _hier_moe(tokens, router_g_w[l], router_g_b[l], router_e_w[l], router_e_b[l],
                      exp_w_gate[l], exp_w_up[l], exp_w_down[l])
        x = x + gt_f * f[:b * seq].reshape(b, seq, d)
        if ctx_full:
            hc = hc + cgt_f * f[b * seq:].reshape(b, n_ctx, d)
    return _rms(x, final_g)
```

```cpp
#include <hip/hip_runtime.h>
#include <cstdio>
#include <cstdint>

#define LAS __attribute__((address_space(3)))
#define GAS __attribute__((address_space(1)))
typedef unsigned short bf16_t;
typedef short bf16x8 __attribute__((ext_vector_type(8)));
typedef float f32x4 __attribute__((ext_vector_type(4)));
typedef float f32x2 __attribute__((ext_vector_type(2)));
typedef unsigned u32x4 __attribute__((ext_vector_type(4)));
typedef unsigned u32x2 __attribute__((ext_vector_type(2)));

#ifndef MK_ONE_LAUNCH
#define MK_ONE_LAUNCH 1
#endif

constexpr int D = 2048, NB = 8, SEQ = 4096, M = NB * SEQ, CL = 256, MC = NB * CL;
constexpr int WA = 1024, NE = 32, EFF = 512;
constexpr int NASG = 2 * M, MAXROWS = NASG + NE * 256, MAXTILES = MAXROWS / 256;
constexpr float EPS = 1e-6f;
constexpr int NWAVES = 8, NTHREADS = 512;

constexpr size_t MiB = 1u << 20;
constexpr size_t WS_CTL = 0, CTL_ZERO_BYTES = 1 * MiB;
constexpr size_t WS_MOD = 1 * MiB;
constexpr size_t WS_LB = 2 * MiB;
constexpr size_t WS_RW = 3 * MiB;
constexpr size_t WS_RB = 4 * MiB;
constexpr size_t WS_MP = 8 * MiB;
constexpr size_t WS_WIN0 = 22 * MiB, WS_WOUT0 = 50 * MiB, WS_WIN1 = 58 * MiB, WS_WOUT1 = 82 * MiB, WS_EGU = 90 * MiB, WS_EDN = 346 * MiB;
constexpr size_t WS_HB = 474 * MiB;
constexpr size_t WS_R = 610 * MiB;
constexpr size_t WS_Q = WS_R, PROJ_STRIDE = 64 * MiB;
constexpr size_t WS_CTXP = WS_R + 7 * 64 * MiB, CTXP_STRIDE = 4 * MiB;
constexpr size_t WS_OF = WS_CTXP + 12 * MiB, WS_OB = WS_OF + 64 * MiB;
constexpr size_t WS_Y = WS_R, WS_HMID = WS_R + 288 * MiB;
constexpr size_t WS_P1 = WS_R, P1_STRIDE = 128 * MiB;
constexpr size_t WS_RT = 1198 * MiB;
constexpr size_t RT_ASG_E = WS_RT, RT_ASG_R = RT_ASG_E + 262144, RT_ASG_W = RT_ASG_R + 262144, RT_POS = RT_ASG_W + 262144,
                 RT_BUF_TOK = RT_POS + 262144, RT_BUF_W = RT_BUF_TOK + 294912, RT_CNT = RT_BUF_W + 294912;
constexpr size_t WS_XB = 1201 * MiB;
constexpr size_t WS_END = 1329 * MiB;
static_assert(WS_OB + 64 * MiB <= WS_RT && RT_CNT + 32768 <= WS_XB && WS_HMID + 72 * MiB <= WS_RT && WS_P1 + 3 * P1_STRIDE <= WS_RT, "ws map");
constexpr int CW_BAR = 4096;

constexpr int RING_BYTES = 131072;
constexpr int MISC_OFF = 147456;
constexpr int LDS_BYTES = 163840;

typedef __bf16 bf16x2_t __attribute__((ext_vector_type(2)));
__device__ __forceinline__ unsigned cvt_pk_bf16(float lo, float hi) { const f32x2 v = {lo, hi}; return __builtin_bit_cast(unsigned, __builtin_convertvector(v, bf16x2_t)); }
__device__ __forceinline__ float bf_lo(unsigned w) { return __uint_as_float(w << 16); }
__device__ __forceinline__ float bf_hi(unsigned w) { return __uint_as_float(w & 0xffff0000u); }
__device__ __forceinline__ float bf2f(bf16_t b) { return __uint_as_float(((unsigned)b) << 16); }
__device__ __forceinline__ float wave_sum(float v) {
#pragma unroll
    for (int o = 1; o < 64; o <<= 1) v += __shfl_xor(v, o);
    return v;
}
__device__ __forceinline__ float fast_sigmoid(float x) { return __builtin_amdgcn_rcpf(1.0f + __expf(-x)); }
__device__ __forceinline__ float silu_f(float x) { return x * fast_sigmoid(x); }
__device__ __forceinline__ float gelu_tanh_f(float x) { const float u = 0.7978845608028654f * (x + 0.044715f * x * x * x); return x * fast_sigmoid(2.0f * u); }
#define LDS_WAIT() asm volatile("s_waitcnt lgkmcnt(0)" ::: "memory")
#define VM_WAIT() asm volatile("s_waitcnt vmcnt(0)" ::: "memory")
#define LDS_BARRIER() do { asm volatile("s_waitcnt lgkmcnt(0)" ::: "memory"); __builtin_amdgcn_s_barrier(); asm volatile("" ::: "memory"); } while (0)

#define XB_TMO      128
#define XB_XCNT(j)  (256  + 64 * (j))
#define XB_XSUB(j)  (1280 + 64 * (j))
#define XB_XGEN(j)  (2304 + 64 * (j))
#define XB_TOP      3328
#define XB_TOPGEN   3392
#define XCD_BAR_WORDS 3456
#define XB_SPIN_CAP (1u << 22)
__device__ __forceinline__ unsigned xb_ld(unsigned* p)              { return __hip_atomic_load(p, __ATOMIC_RELAXED, __HIP_MEMORY_SCOPE_AGENT); }
__device__ __forceinline__ unsigned xb_add(unsigned* p, unsigned v) { return __hip_atomic_fetch_add(p, v, __ATOMIC_RELAXED, __HIP_MEMORY_SCOPE_AGENT); }
__device__ __forceinline__ unsigned xb_xcc_id() { return (unsigned)__builtin_amdgcn_s_getreg((3 << 11) | 20) & 0xFu; }
#define XB_SPIN(cond, bar) do { unsigned _sp = 0; while (cond) { __builtin_amdgcn_s_sleep(1); \
    if ((++_sp & 255u) == 0u) { if (xb_ld(&(bar)[XB_TMO])) break; if (_sp > XB_SPIN_CAP) { atomicAdd(&(bar)[XB_TMO], 1u); break; } } } } while (0)
struct XcdBarrier { unsigned* bar; unsigned x; volatile LAS unsigned* st; };
__device__ __forceinline__ XcdBarrier xcd_barrier_post(unsigned* bar, volatile LAS unsigned* st) {
    XcdBarrier b; b.bar = bar; b.x = xb_xcc_id(); b.st = st;
    if (threadIdx.x == 0) (void)xb_add(&bar[XB_XCNT(b.x)], 1u);
    return b;
}
__device__ __forceinline__ void xcd_barrier_complete(unsigned* bar, unsigned x, unsigned& nloc, unsigned& nx) {
    const unsigned G = gridDim.x * gridDim.y * gridDim.z;
    unsigned sum, cnt, mine, sp = 0u;
    for (;;) {
        sum = 0u; cnt = 0u; mine = 0u;
#pragma unroll
        for (unsigned j = 0; j < 16; ++j) { const unsigned c = xb_ld(&bar[XB_XCNT(j)]); sum += c; cnt += (c > 0u) ? 1u : 0u; mine = (j == x) ? c : mine; }
        if (sum == G) break;
        __builtin_amdgcn_s_sleep(1);
        if ((++sp & 255u) == 0u) { if (xb_ld(&bar[XB_TMO])) break; if (sp > XB_SPIN_CAP) { atomicAdd(&bar[XB_TMO], 1u); break; } }
    }
    nloc = mine > 0u ? mine : 1u; nx = cnt > 0u ? cnt : 1u;
}
__device__ __forceinline__ void xcd_barrier(const XcdBarrier& b) {
    asm volatile("s_waitcnt vmcnt(0)" ::: "memory");
    __syncthreads();
    if (threadIdx.x == 0) {
        unsigned* bar = b.bar;
        __builtin_amdgcn_s_waitcnt(0);
        unsigned nloc = b.st[0], nx = b.st[1];
        if (nloc == 0u) { xcd_barrier_complete(bar, b.x, nloc, nx); b.st[0] = nloc; b.st[1] = nx; }
        const unsigned old = xb_add(&bar[XB_XSUB(b.x)], 1u);
        const unsigned gen = old / nloc;
        if (old + 1u == (gen + 1u) * nloc) {
            __builtin_amdgcn_fence(__ATOMIC_RELEASE, "agent");
            asm volatile("s_waitcnt vmcnt(0)" ::: "memory");
            const unsigned og = xb_add(&bar[XB_TOP], 1u);
            const unsigned tg = og / nx;
            if (og + 1u == (tg + 1u) * nx) xb_add(&bar[XB_TOPGEN], 1u);
            else XB_SPIN(xb_ld(&bar[XB_TOPGEN]) == tg, bar);
            __builtin_amdgcn_fence(__ATOMIC_ACQUIRE, "agent");
            xb_add(&bar[XB_XGEN(b.x)], 1u);
            asm volatile("s_waitcnt vmcnt(0)" ::: "memory");
        } else {
            XB_SPIN(xb_ld(&bar[XB_XGEN(b.x)]) == gen, bar);
            __builtin_amdgcn_fence(__ATOMIC_ACQUIRE, "agent");
            asm volatile("s_waitcnt vmcnt(0)" ::: "memory");
        }
    }
    __syncthreads();
}

namespace pg8 {
constexpr int BM = 256, BK = 64, HALF = 128, HTB = HALF * BK * 2, STAGE_BYTES = 8 * HTB, NXCD = 8, WGM = 8;
__host__ __device__ __forceinline__ int lds_byte(int r, int c) { const int st = (r >> 4) * 2 + (c >> 5), rr = r & 15, cc = c & 31, ob = rr * 64 + cc * 2; return st * 1024 + (ob ^ (((ob >> 9) & 1) << 5)); }
__host__ __device__ __forceinline__ void stage_rc(int b, int& R, int& C) { const int st = b / 1024, sb = b % 1024, swz = sb ^ (((sb >> 9) & 1) << 5); R = (st >> 1) * 16 + swz / 64; C = (st & 1) * 32 + (swz % 64) / 2; }
__host__ __device__ __forceinline__ int perm32(int rho) { const int n = rho >> 4, i = rho & 15; return 8 * (i >> 2) + 4 * n + (i & 3); }
struct Unit { int pm, pn, pb; };
struct Gemm { const bf16_t* A; const bf16_t* Bt; int K; const int* rowtab; };
struct StaticOrder {
    int nM, nN, nwg, G, c;
    __device__ void init(int Mr, int N, int G_, int c_) { nM = Mr / BM; nN = N / BM; nwg = nM * nN; G = G_; c = c_; }
    __device__ __forceinline__ bool map(long Lu, Unit& u) const {
        if (Lu >= nwg) return false;
        int wgid = (int)Lu; { const int q = nwg / NXCD, r = nwg % NXCD, xcd = wgid % NXCD, off = wgid / NXCD; wgid = (xcd < r ? xcd * (q + 1) : r * (q + 1) + (xcd - r) * q) + off; }
        const int nig = WGM * nN, gid = wgid / nig, fm = gid * WGM, gsz = (nM - fm) < WGM ? (nM - fm) : WGM;
        u.pm = fm + ((wgid % nig) % gsz); u.pn = (wgid % nig) / gsz; u.pb = u.pn; return true;
    }
    __device__ __forceinline__ bool next(int i, Unit& u) const { return map((long)i * G + c, u); }
};

template <class Epi, class Sched, bool GATHER>
__device__ __forceinline__ void gemm_phase(LAS unsigned char* lds, const Gemm g, const Sched& S, const Epi& E) {
    const int tid = threadIdx.x, wid = __builtin_amdgcn_readfirstlane(tid >> 6), lane = tid & 63, wr = wid >> 2, wc = wid & 3, fr = lane & 15, fq = lane >> 4;
    const int K = g.K, nt = K / BK;
    unsigned voffB[2]; int rA[2]; unsigned cA2[2];
#pragma unroll
    for (int i = 0; i < 2; ++i) { int R, C; stage_rc(tid * 16 + i * 8192, R, C); const int Rb = Epi::COLMAP64 ? (64 * (R >> 5) + perm32(R & 31)) : (Epi::PERM ? ((R & ~31) + perm32(R & 31)) : R);
        rA[i] = R; cA2[i] = (unsigned)C * 2u; voffB[i] = (unsigned)(Rb * K + C) * 2u; }
    const size_t kstep = (size_t)(BK * 2);
    const size_t hstep = (size_t)(Epi::COLMAP64 ? 32 : HALF) * K * 2;
    const size_t tstep = (size_t)BM * K * 2;
    const unsigned ldsw = (unsigned)wid * 1024u;
    const int aoff = lds_byte(wr * 64 + fr, fq * 8), boff = lds_byte(wc * 32 + fr, fq * 8);
    const unsigned rowbytes = (unsigned)K * 2u;
#define PG8_SA(b, h) (((b) * 2 + (h)) * HTB)
#define PG8_SB(b, h) ((4 + (b) * 2 + (h)) * HTB)
#define PG8_STAGE(bufoff, gbase, voff) do { _Pragma("unroll") for (int _i = 0; _i < 2; ++_i) \
        __builtin_amdgcn_global_load_lds((const unsigned*)((const char*)(gbase) + (voff)[_i]), (LAS unsigned*)(lds + (bufoff) + ldsw + _i * 8192), 16, 0, 0); } while (0)
#define PG8_STAGE2(bufoff, gbase, o0, o1) do { \
        __builtin_amdgcn_global_load_lds((const unsigned*)((const char*)(gbase) + (o0)), (LAS unsigned*)(lds + (bufoff) + ldsw), 16, 0, 0); \
        __builtin_amdgcn_global_load_lds((const unsigned*)((const char*)(gbase) + (o1)), (LAS unsigned*)(lds + (bufoff) + ldsw + 8192), 16, 0, 0); } while (0)
#define PG8_LDA(dst, b, h) do { _Pragma("unroll") for (int m = 0; m < 4; ++m) _Pragma("unroll") for (int k = 0; k < 2; ++k) dst[m][k] = *(const LAS bf16x8*)(lds + PG8_SA(b, h) + aoff + m * 2048 + k * 1024); } while (0)
#define PG8_LDB(dst, b, h) do { _Pragma("unroll") for (int n = 0; n < 2; ++n) _Pragma("unroll") for (int k = 0; k < 2; ++k) dst[n][k] = *(const LAS bf16x8*)(lds + PG8_SB(b, h) + boff + n * 2048 + k * 1024); } while (0)
#define PG8_MMA(ai, bj, At, Bt) do { __builtin_amdgcn_s_setprio(1); _Pragma("unroll") for (int m = 0; m < 4; ++m) _Pragma("unroll") for (int n = 0; n < 2; ++n) _Pragma("unroll") for (int k = 0; k < 2; ++k) \
        acc[ai][bj][m][n] = __builtin_amdgcn_mfma_f32_16x16x32_bf16(Bt[n][k], At[m][k], acc[ai][bj][m][n], 0, 0, 0); __builtin_amdgcn_s_setprio(0); } while (0)
#define PG8_WAIT_V(n) asm volatile("s_waitcnt vmcnt(" #n ")" ::: "memory")
#define PG8_WAIT_L(n) asm volatile("s_waitcnt lgkmcnt(" #n ")" ::: "memory")
#define PG8_BAR __builtin_amdgcn_s_barrier()
#define PG8_SCHED __builtin_amdgcn_sched_barrier(0)
#define PG8_AOFF(dst, u) do { _Pragma("unroll") for (int _h = 0; _h < 2; ++_h) _Pragma("unroll") for (int _i = 0; _i < 2; ++_i) { \
        const int _r = (u).pm * BM + _h * HALF + rA[_i]; const unsigned _row = GATHER ? (unsigned)g.rowtab[_r] : (unsigned)_r; dst[_h][_i] = _row * rowbytes + cA2[_i]; } } while (0)
    Unit cur, nxt; int ui = 0;
    if (!S.next(0, cur)) return;
    f32x4 acc[2][2][4][2];
#pragma unroll
    for (int a = 0; a < 2; ++a)
#pragma unroll
        for (int b = 0; b < 2; ++b)
#pragma unroll
            for (int m = 0; m < 4; ++m)
#pragma unroll
                for (int n = 0; n < 2; ++n) acc[a][b][m][n] = (f32x4){0.f, 0.f, 0.f, 0.f};
    bf16x8 At[4][2], B0[2][2], B1[2][2];
    unsigned ga[2][2], gn[2][2];
    PG8_AOFF(ga, cur);
    const char* const A0 = (const char*)g.A;
    const char* cB = (const char*)g.Bt + (size_t)cur.pb * tstep;
    PG8_STAGE(PG8_SB(0, 0), cB, voffB); PG8_STAGE2(PG8_SA(0, 0), A0, ga[0][0], ga[0][1]); PG8_STAGE(PG8_SB(0, 1), cB + hstep, voffB); PG8_STAGE2(PG8_SA(0, 1), A0, ga[1][0], ga[1][1]);
    if (wr == 1) PG8_BAR;
    PG8_WAIT_V(4); PG8_BAR;
    PG8_STAGE(PG8_SB(1, 0), cB + kstep, voffB); PG8_STAGE2(PG8_SA(1, 0), A0 + kstep, ga[0][0], ga[0][1]); PG8_STAGE(PG8_SB(1, 1), cB + hstep + kstep, voffB);
    PG8_WAIT_V(6); PG8_BAR;
    for (;;) {
        const bool has_next = S.next(ui + 1, nxt);
        if (has_next) { PG8_AOFF(gn, nxt); } else {
#pragma unroll
            for (int h = 0; h < 2; ++h)
#pragma unroll
                for (int i = 0; i < 2; ++i) gn[h][i] = ga[h][i]; }
        const char* nB = has_next ? (const char*)g.Bt + (size_t)nxt.pb * tstep : cB;
        for (int t = 0; t < nt; t += 2) {
            const bool last = (t == nt - 2);
            const char* a1 = A0 + (size_t)(t + 1) * kstep;
            const char* a2 = last ? A0 : A0 + (size_t)(t + 2) * kstep; const char* b2 = last ? nB : cB + (size_t)(t + 2) * kstep;
            const char* a3 = a2 + kstep; const char* b3 = b2 + kstep;
            const unsigned o00 = last ? gn[0][0] : ga[0][0], o01 = last ? gn[0][1] : ga[0][1], o10 = last ? gn[1][0] : ga[1][0], o11 = last ? gn[1][1] : ga[1][1];
            PG8_LDB(B0, 0, 0); PG8_SCHED; PG8_LDA(At, 0, 0); PG8_STAGE2(PG8_SA(1, 1), a1, ga[1][0], ga[1][1]);
            PG8_WAIT_L(8); PG8_BAR; PG8_WAIT_L(0); PG8_MMA(0, 0, At, B0); PG8_BAR; PG8_SCHED;
            PG8_LDB(B1, 0, 1); PG8_STAGE(PG8_SB(0, 0), b2, voffB);
            PG8_BAR; PG8_WAIT_L(0); PG8_MMA(0, 1, At, B1); PG8_BAR;
            PG8_LDA(At, 0, 1); PG8_STAGE2(PG8_SA(0, 0), a2, o00, o01);
            PG8_BAR; PG8_WAIT_L(0); PG8_MMA(1, 0, At, B0); PG8_BAR; PG8_SCHED;
            PG8_STAGE(PG8_SB(0, 1), b2 + hstep, voffB);
            PG8_WAIT_V(6); PG8_BAR; PG8_MMA(1, 1, At, B1); PG8_BAR;
            PG8_LDB(B0, 1, 0); PG8_SCHED; PG8_LDA(At, 1, 0); PG8_STAGE2(PG8_SA(0, 1), a2, o10, o11);
            PG8_WAIT_L(8); PG8_BAR; PG8_WAIT_L(0); PG8_MMA(0, 0, At, B0); PG8_BAR; PG8_SCHED;
            PG8_LDB(B1, 1, 1); PG8_STAGE(PG8_SB(1, 0), b3, voffB);
            PG8_BAR; PG8_WAIT_L(0); PG8_MMA(0, 1, At, B1); PG8_BAR;
            PG8_LDA(At, 1, 1); PG8_STAGE2(PG8_SA(1, 0), a3, o00, o01);
            PG8_BAR; PG8_WAIT_L(0); PG8_MMA(1, 0, At, B0); PG8_BAR; PG8_SCHED;
            PG8_STAGE(PG8_SB(1, 1), b3 + hstep, voffB);
            PG8_WAIT_V(6); PG8_BAR; PG8_MMA(1, 1, At, B1); PG8_BAR;
        }
        E(acc, cur, wr, wc, fr, fq);
        if (!has_next) break;
#pragma unroll
        for (int a = 0; a < 2; ++a)
#pragma unroll
            for (int b = 0; b < 2; ++b)
#pragma unroll
                for (int m = 0; m < 4; ++m)
#pragma unroll
                    for (int n = 0; n < 2; ++n) acc[a][b][m][n] = (f32x4){0.f, 0.f, 0.f, 0.f};
        cur = nxt; cB = nB; ++ui;
#pragma unroll
        for (int h = 0; h < 2; ++h)
#pragma unroll
            for (int i = 0; i < 2; ++i) ga[h][i] = gn[h][i];
    }
    PG8_WAIT_V(0);
    if (wr == 0) PG8_BAR;
    PG8_BAR;
#undef PG8_SA
#undef PG8_SB
#undef PG8_STAGE
#undef PG8_STAGE2
#undef PG8_LDA
#undef PG8_LDB
#undef PG8_MMA
#undef PG8_WAIT_V
#undef PG8_WAIT_L
#undef PG8_BAR
#undef PG8_SCHED
#undef PG8_AOFF
}
}

struct Params {
    const float* in[27];
    float* out;
    unsigned char* ws;
    int ph_lo, ph_hi;
};

struct EpiInProj0 {
    static constexpr bool PERM = true, COLMAP64 = false;
    unsigned char* ws; const float* lb;
    __device__ __forceinline__ void operator()(const f32x4 (&acc)[2][2][4][2], const pg8::Unit& u, int wr, int wc, int fr, int fq) const {
        const int t = u.pn >> 2;
        const bool ctx = u.pm >= M / 256;
        bf16_t* base = ctx ? (bf16_t*)(ws + WS_CTXP + (size_t)(t - 1) * CTXP_STRIDE) : (bf16_t*)(ws + WS_Q + (size_t)t * PROJ_STRIDE);
        const int row0 = (ctx ? u.pm * 256 - M : u.pm * 256) + wr * 64 + fr;
        const int col0 = (u.pn & 3) * 256 + wc * 32 + 8 * fq;
        const bool headmajor = t < 4;
        const int Ls = ctx ? CL : SEQ;
        f32x4 lbv[2][2];
        if (t == 1 || t == 2) {
#pragma unroll
            for (int bj = 0; bj < 2; ++bj)
#pragma unroll
                for (int n = 0; n < 2; ++n) lbv[bj][n] = *(const f32x4*)(lb + (t - 1) * 1024 + col0 + bj * 128 + 4 * n);
        }
#pragma unroll
        for (int ai = 0; ai < 2; ++ai)
#pragma unroll
            for (int m = 0; m < 4; ++m) { const int rr = row0 + ai * 128 + m * 16; const int bb = rr / Ls, pos = rr - bb * Ls;
#pragma unroll
                for (int bj = 0; bj < 2; ++bj) { f32x4 v0 = acc[ai][bj][m][0], v1 = acc[ai][bj][m][1]; u32x4 w;
                    bf16_t* dstp = headmajor ? base + ((size_t)(bb * 8 + (u.pn & 3) * 2 + bj) * Ls + pos) * 128 + wc * 32 + 8 * fq : base + (size_t)rr * 1024 + col0 + bj * 128;
                    if (t == 1 || t == 2) {
                        _Float16 hv[8];
#pragma unroll
                        for (int j = 0; j < 4; ++j) { const float l0 = lbv[bj][0][j], l1 = lbv[bj][1][j];
                            const float f0 = l0 + (1.0f - l0) * fast_sigmoid(v0[j]), f1 = l1 + (1.0f - l1) * fast_sigmoid(v1[j]);
                            hv[j] = (_Float16)f0; hv[4 + j] = (_Float16)f1; }
                        w.x = (unsigned)__builtin_bit_cast(unsigned short, hv[0]) | ((unsigned)__builtin_bit_cast(unsigned short, hv[1]) << 16);
                        w.y = (unsigned)__builtin_bit_cast(unsigned short, hv[2]) | ((unsigned)__builtin_bit_cast(unsigned short, hv[3]) << 16);
                        w.z = (unsigned)__builtin_bit_cast(unsigned short, hv[4]) | ((unsigned)__builtin_bit_cast(unsigned short, hv[5]) << 16);
                        w.w = (unsigned)__builtin_bit_cast(unsigned short, hv[6]) | ((unsigned)__builtin_bit_cast(unsigned short, hv[7]) << 16);
                    } else {
                        if (t == 0 || t == 4) {
#pragma unroll
                            for (int j = 0; j < 4; ++j) { v0[j] = silu_f(v0[j]); v1[j] = silu_f(v1[j]); }
                        } else if (t >= 5) {
#pragma unroll
                            for (int j = 0; j < 4; ++j) { v0[j] = gelu_tanh_f(v0[j]); v1[j] = gelu_tanh_f(v1[j]); }
                        }
                        w.x = cvt_pk_bf16(v0[0], v0[1]); w.y = cvt_pk_bf16(v0[2], v0[3]); w.z = cvt_pk_bf16(v1[0], v1[1]); w.w = cvt_pk_bf16(v1[2], v1[3]);
                    }
                    *(u32x4*)dstp = w; } }
    }
};
struct InProj0Order {
    pg8::StaticOrder so;
    __device__ __forceinline__ bool next(int i, pg8::Unit& u) const {
        const long Lu = (long)i * so.G + so.c;
        if (Lu < so.nwg) return so.map(Lu, u);
        const int r = (int)(Lu - so.nwg); if (r >= 96) return false;
        u.pm = M / 256 + r / 12; u.pn = 4 + r % 12; u.pb = u.pn; return true;
    }
};
struct EpiOddIn {
    static constexpr bool PERM = true, COLMAP64 = false;
    bf16_t* Z; bf16_t* BG;
    __device__ __forceinline__ void operator()(const f32x4 (&acc)[2][2][4][2], const pg8::Unit& u, int wr, int wc, int fr, int fq) const {
        const int row0 = u.pm * 256 + wr * 64 + fr;
        if (u.pn < 16) {
            const int col0 = u.pn * 128 + wc * 32 + 8 * fq;
#pragma unroll
            for (int ai = 0; ai < 2; ++ai)
#pragma unroll
                for (int m = 0; m < 4; ++m) { const f32x4 v0 = acc[ai][0][m][0] * acc[ai][1][m][0], v1 = acc[ai][0][m][1] * acc[ai][1][m][1]; u32x4 w;
                    w.x = cvt_pk_bf16(v0[0], v0[1]); w.y = cvt_pk_bf16(v0[2], v0[3]); w.z = cvt_pk_bf16(v1[0], v1[1]); w.w = cvt_pk_bf16(v1[2], v1[3]);
                    *(u32x4*)(Z + (size_t)(row0 + ai * 128 + m * 16) * 2048 + col0) = w; }
        } else {
            const int col0 = (u.pn - 16) * 256 + wc * 32 + 8 * fq;
#pragma unroll
            for (int ai = 0; ai < 2; ++ai)
#pragma unroll
                for (int m = 0; m < 4; ++m) { bf16_t* rowp = BG + (size_t)(row0 + ai * 128 + m * 16) * 2048 + col0;
#pragma unroll
                    for (int bj = 0; bj < 2; ++bj) { const f32x4 v0 = acc[ai][bj][m][0], v1 = acc[ai][bj][m][1]; u32x4 w;
                        w.x = cvt_pk_bf16(v0[0], v0[1]); w.y = cvt_pk_bf16(v0[2], v0[3]); w.z = cvt_pk_bf16(v1[0], v1[1]); w.w = cvt_pk_bf16(v1[2], v1[3]);
                        *(u32x4*)(rowp + bj * 128) = w; } }
        }
    }
};
template <bool IN_F32> struct EpiResid {
    static constexpr bool PERM = true, COLMAP64 = false;
    const void* xin; bf16_t* xout; const float* gate;
    __device__ __forceinline__ void operator()(const f32x4 (&acc)[2][2][4][2], const pg8::Unit& u, int wr, int wc, int fr, int fq) const {
        const int row0 = u.pm * 256 + wr * 64 + fr, col0 = u.pn * 256 + wc * 32 + 8 * fq;
        const int b = (u.pm * 256) / SEQ;
        unsigned yp[2][4][2][4];
#pragma unroll
        for (int bj = 0; bj < 2; ++bj)
#pragma unroll
            for (int n = 0; n < 2; ++n) { const f32x4 gv = *(const f32x4*)(gate + (size_t)b * 12288 + col0 + bj * 128 + n * 4);
#pragma unroll
                for (int ai = 0; ai < 2; ++ai)
#pragma unroll
                    for (int m = 0; m < 4; ++m) { const f32x4 y = gv * acc[ai][bj][m][n]; yp[ai][m][bj][2 * n] = cvt_pk_bf16(y.x, y.y); yp[ai][m][bj][2 * n + 1] = cvt_pk_bf16(y.z, y.w); } }
        asm volatile("" ::: "memory");
        if (IN_F32) {
#pragma unroll
            for (int ai = 0; ai < 2; ++ai) {
                f32x4 xi[4][2][2];
#pragma unroll
                for (int m = 0; m < 4; ++m) { const float* xp = (const float*)xin + (size_t)(row0 + ai * 128 + m * 16) * D + col0;
#pragma unroll
                    for (int bj = 0; bj < 2; ++bj) { xi[m][bj][0] = *(const f32x4*)(xp + bj * 128); xi[m][bj][1] = *(const f32x4*)(xp + bj * 128 + 4); } }
                asm volatile("" ::: "memory");
#pragma unroll
                for (int m = 0; m < 4; ++m) { bf16_t* op = xout + (size_t)(row0 + ai * 128 + m * 16) * D + col0;
#pragma unroll
                    for (int bj = 0; bj < 2; ++bj) { const unsigned* y = yp[ai][m][bj]; const f32x4 x0 = xi[m][bj][0], x1 = xi[m][bj][1];
                        u32x4 w; w.x = cvt_pk_bf16(x0.x + bf_lo(y[0]), x0.y + bf_hi(y[0])); w.y = cvt_pk_bf16(x0.z + bf_lo(y[1]), x0.w + bf_hi(y[1]));
                        w.z = cvt_pk_bf16(x1.x + bf_lo(y[2]), x1.y + bf_hi(y[2])); w.w = cvt_pk_bf16(x1.z + bf_lo(y[3]), x1.w + bf_hi(y[3]));
                        *(u32x4*)(op + bj * 128) = w; } }
                asm volatile("" ::: "memory");
            }
        } else {
            u32x4 xi[2][4][2];
#pragma unroll
            for (int ai = 0; ai < 2; ++ai)
#pragma unroll
                for (int m = 0; m < 4; ++m) { const bf16_t* xp = (const bf16_t*)xin + (size_t)(row0 + ai * 128 + m * 16) * D + col0;
#pragma unroll
                    for (int bj = 0; bj < 2; ++bj) xi[ai][m][bj] = *(const u32x4*)(xp + bj * 128); }
            asm volatile("" ::: "memory");
#pragma unroll
            for (int ai = 0; ai < 2; ++ai)
#pragma unroll
                for (int m = 0; m < 4; ++m) { bf16_t* op = xout + (size_t)(row0 + ai * 128 + m * 16) * D + col0;
#pragma unroll
                    for (int bj = 0; bj < 2; ++bj) { const unsigned* y = yp[ai][m][bj]; const u32x4 xw = xi[ai][m][bj];
                        u32x4 w; w.x = cvt_pk_bf16(bf_lo(xw.x) + bf_lo(y[0]), bf_hi(xw.x) + bf_hi(y[0])); w.y = cvt_pk_bf16(bf_lo(xw.y) + bf_lo(y[1]), bf_hi(xw.y) + bf_hi(y[1]));
                        w.z = cvt_pk_bf16(bf_lo(xw.z) + bf_lo(y[2]), bf_hi(xw.z) + bf_hi(y[2])); w.w = cvt_pk_bf16(bf_lo(xw.w) + bf_lo(y[3]), bf_hi(xw.w) + bf_hi(y[3]));
                        *(u32x4*)(op + bj * 128) = w; } }
        }
    }
};
struct EpiGateUp {
    static constexpr bool PERM = true, COLMAP64 = false;
    bf16_t* H;
    __device__ __forceinline__ void operator()(const f32x4 (&acc)[2][2][4][2], const pg8::Unit& u, int wr, int wc, int fr, int fq) const {
        const int row0 = u.pm * 256 + wr * 64 + fr, col0 = u.pn * 128 + wc * 32 + 8 * fq;
#pragma unroll
        for (int ai = 0; ai < 2; ++ai)
#pragma unroll
            for (int m = 0; m < 4; ++m) { bf16_t* rowp = H + (size_t)(row0 + ai * 128 + m * 16) * EFF + col0;
                f32x4 v0, v1;
#pragma unroll
                for (int j = 0; j < 4; ++j) { v0[j] = silu_f(acc[ai][0][m][0][j]) * acc[ai][1][m][0][j]; v1[j] = silu_f(acc[ai][0][m][1][j]) * acc[ai][1][m][1][j]; }
                u32x4 w; w.x = cvt_pk_bf16(v0[0], v0[1]); w.y = cvt_pk_bf16(v0[2], v0[3]); w.z = cvt_pk_bf16(v1[0], v1[1]); w.w = cvt_pk_bf16(v1[2], v1[3]);
                *(u32x4*)rowp = w; }
    }
};
struct EpiDown {
    static constexpr bool PERM = true, COLMAP64 = false;
    bf16_t* Y; const float* bw;
    __device__ __forceinline__ void operator()(const f32x4 (&acc)[2][2][4][2], const pg8::Unit& u, int wr, int wc, int fr, int fq) const {
        const int row0 = u.pm * 256 + wr * 64 + fr, col0 = u.pn * 256 + wc * 32 + 8 * fq;
        float sc[2][4];
#pragma unroll
        for (int ai = 0; ai < 2; ++ai)
#pragma unroll
            for (int m = 0; m < 4; ++m) sc[ai][m] = bw[row0 + ai * 128 + m * 16];
        asm volatile("" ::: "memory");
#pragma unroll
        for (int ai = 0; ai < 2; ++ai)
#pragma unroll
            for (int m = 0; m < 4; ++m) { const int row = row0 + ai * 128 + m * 16; bf16_t* rowp = Y + (size_t)row * D + col0;
#pragma unroll
                for (int bj = 0; bj < 2; ++bj) { const f32x4 v0 = acc[ai][bj][m][0] * sc[ai][m], v1 = acc[ai][bj][m][1] * sc[ai][m]; u32x4 w;
                    w.x = cvt_pk_bf16(v0[0], v0[1]); w.y = cvt_pk_bf16(v0[2], v0[3]); w.z = cvt_pk_bf16(v1[0], v1[1]); w.w = cvt_pk_bf16(v1[2], v1[3]);
                    *(u32x4*)(rowp + bj * 128) = w; } }
    }
};
struct MoeOrder {
    int G, c, ntn, nunits; const LAS int* tile_e;
    __device__ __forceinline__ bool next(int i, pg8::Unit& u) const {
        const int Lu = i * G + c; if (Lu >= nunits) return false;
        const int tile = Lu / ntn, pn = Lu - tile * ntn;
        u.pm = tile; u.pn = pn; u.pb = tile_e[tile] * ntn + pn; return true;
    }
};

struct TrItem { const float* src; bf16_t* dst; int ldn, ldk; };
#define TRANSPOSE_LOAD(it, tv) do { _Pragma("unroll") for (int _i = 0; _i < 32; ++_i) tv[_i] = __builtin_nontemporal_load((it).src + (size_t)(2 * _i + (lane >> 5)) * (it).ldn + (lane & 31)); } while (0)
#define TRANSPOSE_STORE(it, tv) do { \
    _Pragma("unroll") for (int _i = 0; _i < 32; ++_i) scr[(2 * _i + (lane >> 5)) * 33 + (lane & 31)] = tv[_i]; \
    LDS_WAIT(); asm volatile("" ::: "memory"); \
    { const int _c = lane & 7; \
      _Pragma("unroll") for (int _j = 0; _j < 4; ++_j) { const int _n = (lane >> 3) + 8 * _j; const LAS float* _sp = scr + (8 * _c) * 33 + _n; \
        u32x4 _o; _o.x = cvt_pk_bf16(_sp[0 * 33], _sp[1 * 33]); _o.y = cvt_pk_bf16(_sp[2 * 33], _sp[3 * 33]); _o.z = cvt_pk_bf16(_sp[4 * 33], _sp[5 * 33]); _o.w = cvt_pk_bf16(_sp[6 * 33], _sp[7 * 33]); \
        *(u32x4*)((it).dst + (size_t)_n * (it).ldk + 8 * _c) = _o; } } \
    LDS_WAIT(); asm volatile("" ::: "memory"); } while (0)
__device__ __forceinline__ TrItem prologue_item(const Params& p, int r) {
    unsigned char* ws = p.ws; TrItem it;
    constexpr int I_IN0 = 32 * 224, I_OUT = 32 * 64, I_IN1 = 32 * 192, I_EXP = 512, NDENSE = I_IN0 + I_OUT + I_IN1 + I_OUT;
    if (r < NDENSE) {
        if (r >= I_IN0 + I_OUT && r < I_IN0 + I_OUT + I_IN1) {
            r -= I_IN0 + I_OUT;
            const int nblk = 192, kb = r / nblk, nb = r % nblk, n0 = 32 * nb;
            const int row = n0 < 2048 ? 256 * (n0 >> 7) + (n0 & 127) : (n0 < 4096 ? 4096 + (n0 - 2048) : 256 * ((n0 - 4096) >> 7) + 128 + ((n0 - 4096) & 127));
            it.src = p.in[17] + (size_t)(64 * kb) * 6144 + n0; it.ldn = 6144; it.dst = (bf16_t*)(ws + WS_WIN1) + (size_t)row * 2048 + 64 * kb; it.ldk = 2048; return it;
        }
        const float* W; bf16_t* WT; int N;
        if (r < I_IN0) { W = p.in[9]; WT = (bf16_t*)(ws + WS_WIN0); N = 7168; }
        else if ((r -= I_IN0) < I_OUT) { W = p.in[10]; WT = (bf16_t*)(ws + WS_WOUT0); N = 2048; }
        else { r -= I_OUT + I_IN1; W = p.in[19]; WT = (bf16_t*)(ws + WS_WOUT1); N = 2048; }
        const int nblk = N / 32, kb = r / nblk, nb = r % nblk;
        it.src = W + (size_t)(64 * kb) * N + 32 * nb; it.ldn = N; it.dst = WT + (size_t)(32 * nb) * 2048 + 64 * kb; it.ldk = 2048; return it;
    }
    r -= NDENSE;
    const int le = r / (3 * I_EXP), rr = r % (3 * I_EXP), which = rr / I_EXP, item = rr % I_EXP;
    if (which < 2) {
        const int kb = item / 16, nb = item % 16, n0 = 32 * nb;
        it.src = (which ? p.in[25] : p.in[24]) + (size_t)le * 2048 * 512 + (size_t)(64 * kb) * 512 + n0; it.ldn = 512;
        it.dst = (bf16_t*)(ws + WS_EGU) + (size_t)le * 1024 * 2048 + (size_t)((n0 >> 7) * 256 + which * 128 + (n0 & 127)) * 2048 + 64 * kb; it.ldk = 2048;
    } else {
        const int kb = item / 64, nb = item % 64;
        it.src = p.in[26] + (size_t)le * 512 * 2048 + (size_t)(64 * kb) * 2048 + 32 * nb; it.ldn = 2048;
        it.dst = (bf16_t*)(ws + WS_EDN) + (size_t)le * 2048 * 512 + (size_t)(32 * nb) * 512 + 64 * kb; it.ldk = 512;
    }
    return it;
}
__device__ __forceinline__ void phase_prologue(const Params& p, LAS unsigned char* lds) {
    const int tid = threadIdx.x, lane = tid & 63, wave = __builtin_amdgcn_readfirstlane(tid >> 6);
    const int gw = blockIdx.x * NWAVES + wave, NGW = gridDim.x * NWAVES;
    unsigned char* ws = p.ws;
    LAS float* SL = (LAS float*)lds;
    for (int idx = tid; idx < 9 * 2048; idx += NTHREADS) { const int r = idx >> 11, k = idx & 2047; const float v = r < 8 ? p.in[1][r * 2048 + k] : p.in[3][k]; SL[idx] = silu_f(v); }
    __syncthreads();
    float* MP = (float*)(ws + WS_MP);
    for (int it = gw; it < 1536; it += NGW) {
        const int l = it / 768, rem = it % 768, cb = rem >> 4, ks = rem & 15;
        const int col0 = cb * 256 + lane * 4, k0 = ks * 128;
        const float* W = p.in[4] + (size_t)l * 2048 * 12288 + col0;
        f32x4 acc[9];
#pragma unroll
        for (int r = 0; r < 9; ++r) acc[r] = (f32x4){0.f, 0.f, 0.f, 0.f};
#pragma unroll 2
        for (int k = k0; k < k0 + 128; k += 4) {
            const f32x4 w0 = __builtin_nontemporal_load((const f32x4*)(W + (size_t)(k + 0) * 12288)), w1 = __builtin_nontemporal_load((const f32x4*)(W + (size_t)(k + 1) * 12288)),
                        w2 = __builtin_nontemporal_load((const f32x4*)(W + (size_t)(k + 2) * 12288)), w3 = __builtin_nontemporal_load((const f32x4*)(W + (size_t)(k + 3) * 12288));
#pragma unroll
            for (int r = 0; r < 9; ++r) { const f32x4 a = *(const LAS f32x4*)(SL + r * 2048 + k); acc[r] += a.x * w0 + a.y * w1 + a.z * w2 + a.w * w3; }
        }
#pragma unroll
        for (int r = 0; r < 9; ++r) *(f32x4*)(MP + ((size_t)((ks * 2 + l) * 9 + r)) * 12288 + col0) = acc[r];
    }
    __syncthreads();
    {
        _Float16* RW = (_Float16*)(ws + WS_RW); float* RB = (float*)(ws + WS_RB);
        for (int idx = blockIdx.x * NTHREADS + tid; idx < 2 * 48 * 2048; idx += gridDim.x * NTHREADS) {
            const int l = idx / (48 * 2048), rem = idx % (48 * 2048), col = rem >> 11, k = rem & 2047;
            float w = 0.f;
            if (col < 4) w = p.in[20][(size_t)l * 2048 * 4 + k * 4 + col]; else if (col < 36) w = p.in[22][(size_t)l * 2048 * 32 + k * 32 + (col - 4)];
            RW[idx] = (_Float16)w;
        }
        if (blockIdx.x == 0 && tid < 96) { const int l = tid / 48, col = tid % 48; float b = 0.f; if (col < 4) b = p.in[21][l * 4 + col]; else if (col < 36) b = p.in[23][l * 32 + col - 4]; RB[tid] = b; }
    }
    {
        LAS float* scr = (LAS float*)(lds + wave * 8704);
        constexpr int NITEMS = 32 * 224 + 32 * 64 + 32 * 192 + 32 * 64 + 64 * 3 * 512;
        const int n = gw < NITEMS ? (NITEMS - gw + NGW - 1) / NGW : 0;
        float tvA[32], tvB[32];
        TrItem iA = prologue_item(p, gw < NITEMS ? gw : NITEMS - 1), iB = iA; TRANSPOSE_LOAD(iA, tvA);
        int k = 0;
        for (; k + 2 < n; k += 2) {
            iB = prologue_item(p, gw + (k + 1) * NGW); TRANSPOSE_LOAD(iB, tvB); TRANSPOSE_STORE(iA, tvA);
            iA = prologue_item(p, gw + (k + 2) * NGW); TRANSPOSE_LOAD(iA, tvA); TRANSPOSE_STORE(iB, tvB);
        }
        { const int r1 = gw + (k + 1) * NGW; iB = prologue_item(p, r1 < NITEMS ? r1 : NITEMS - 1); TRANSPOSE_LOAD(iB, tvB); }
        if (k < n) TRANSPOSE_STORE(iA, tvA);
        if (k + 1 < n) TRANSPOSE_STORE(iB, tvB);
    }
}
__device__ __forceinline__ void phase_finalize(const Params& p) {
    unsigned char* ws = p.ws; const float* MP = (const float*)(ws + WS_MP); float* MOD = (float*)(ws + WS_MOD); float* LB = (float*)(ws + WS_LB);
    const int gt = blockIdx.x * NTHREADS + threadIdx.x, NT = gridDim.x * NTHREADS;
    for (int idx = gt; idx < 2 * 9 * 12288; idx += NT) {
        const int l = idx / (9 * 12288), rem = idx % (9 * 12288), r = rem / 12288, n = rem % 12288;
        float s = p.in[5][l * 12288 + n];
#pragma unroll
        for (int ks = 0; ks < 16; ++ks) s += MP[((size_t)((ks * 2 + l) * 9 + r)) * 12288 + n];
        MOD[idx] = s;
    }
    for (int idx = gt; idx < 2048; idx += NT) { const float r0 = p.in[11][idx], r1 = p.in[11][2048 + idx]; LB[idx] = 1.0f / (1.0f + __expf(r1 - r0)); }
}
__device__ __forceinline__ void norm_row_regs(f32x4 (&v)[8], const float* g, const float* sc, const float* sh, bf16_t* orow, int lane) {
    float s = 0.f;
#pragma unroll
    for (int j = 0; j < 8; ++j) s += (v[j].x * v[j].x + v[j].y * v[j].y) + (v[j].z * v[j].z + v[j].w * v[j].w);
    s = wave_sum(s);
    const float rinv = 1.0f / sqrtf(s * (1.0f / D) + EPS);
#pragma unroll
    for (int j = 0; j < 8; ++j) { const f32x4 gg = ((const f32x4*)g)[lane + 64 * j], cc = ((const f32x4*)sc)[lane + 64 * j], hh = ((const f32x4*)sh)[lane + 64 * j];
        const f32x4 h = v[j] * rinv * gg * (1.0f + cc) + hh;
        u32x2 w; w.x = cvt_pk_bf16(h.x, h.y); w.y = cvt_pk_bf16(h.z, h.w);
        ((u32x2*)orow)[lane + 64 * j] = w; }
}
__device__ __forceinline__ void phase_norm_mix0(const Params& p) {
    const int lane = threadIdx.x & 63, wave = __builtin_amdgcn_readfirstlane(threadIdx.x >> 6);
    const int gw = blockIdx.x * NWAVES + wave, NGW = gridDim.x * NWAVES;
    const float* MOD = (const float*)(p.ws + WS_MOD); bf16_t* HB = (bf16_t*)(p.ws + WS_HB);
    constexpr int NR = M + MC;
    const int n = gw < NR ? (NR - gw + NGW - 1) / NGW : 0;
#define NM_LOAD(v, r_) do { const int _r = (r_) < NR ? (r_) : NR - 1; const float* _x = _r < M ? p.in[0] + (size_t)_r * D : p.in[2] + (size_t)(_r - M) * D; \
        _Pragma("unroll") for (int j = 0; j < 8; ++j) v[j] = __builtin_nontemporal_load((const f32x4*)_x + lane + 64 * j); } while (0)
#define NM_STORE(v, r_) do { const int _r = (r_); const float* _md = MOD + (size_t)(_r < M ? _r / SEQ : 8) * 12288; norm_row_regs(v, p.in[6], _md + 2048, _md, HB + (size_t)_r * D, lane); } while (0)
    f32x4 va[8], vb[8];
    NM_LOAD(va, gw);
    int k = 0;
    for (; k + 2 < n; k += 2) {
        NM_LOAD(vb, gw + (k + 1) * NGW); NM_STORE(va, gw + k * NGW);
        NM_LOAD(va, gw + (k + 2) * NGW); NM_STORE(vb, gw + (k + 1) * NGW);
    }
    NM_LOAD(vb, gw + (k + 1) * NGW);
    if (k < n) NM_STORE(va, gw + k * NGW);
    if (k + 1 < n) NM_STORE(vb, gw + (k + 1) * NGW);
#undef NM_LOAD
#undef NM_STORE
}
__device__ __forceinline__ void phase_scan(const Params& p, LAS unsigned char* lds, int c) {
    const int tid = threadIdx.x, lane = tid & 63, w = __builtin_amdgcn_readfirstlane(tid >> 6), fr = lane & 15, fq = lane >> 4;
    const int b = c >> 5, h = (c >> 2) & 7, dir = (c >> 1) & 1, half = c & 1;
    unsigned char* ws = p.ws;
    const bf16_t* Q = (const bf16_t*)(ws + WS_Q);
    const _Float16* F = (const _Float16*)(ws + WS_Q + (size_t)(1 + dir) * PROJ_STRIDE);
    const bf16_t* V = (const bf16_t*)(ws + WS_Q + 3 * PROJ_STRIDE);
    const _Float16* CF = (const _Float16*)(ws + WS_CTXP + (size_t)dir * CTXP_STRIDE);
    const bf16_t* CV = (const bf16_t*)(ws + WS_CTXP + 2 * CTXP_STRIDE);
    bf16_t* O = (bf16_t*)(ws + (dir ? WS_OB : WS_OF));
    constexpr int QD_STRIDE = 272, KT_STRIDE = 144;
    constexpr int OFF_KET = 64 * QD_STRIDE, OFF_VT = OFF_KET + 128 * KT_STRIDE, OFF_PM = OFF_VT + 64 * KT_STRIDE, OFF_DEC = OFF_PM + 64 * KT_STRIDE, BUF_BYTES = OFF_DEC + 512;
    LAS unsigned char* KD = lds + 2 * BUF_BYTES;
    LAS float* TT = (LAS float*)(KD + 64 * QD_STRIDE);
    LAS unsigned char* QRAW = (LAS unsigned char*)(TT + 4 * 128);
    static_assert(2 * BUF_BYTES + 2 * 64 * QD_STRIDE + 4 * 128 * 4 <= MISC_OFF, "scan LDS");
#define SCAN_ROWBASE(t_, rb_, isctx_) const bool isctx_ = (t_) < 4; size_t rb_; { const int _n = isctx_ ? (t_) : (t_) - 4; const int _nch = isctx_ ? 4 : 64; const int _chn = dir ? _nch - 1 - _n : _n; \
        rb_ = (size_t)(b * 8 + h) * (isctx_ ? CL : SEQ) + (size_t)_chn * 64; }
    if (w >= 4) {
        const int pw = w - 4;
        const int k0 = 2 * lane; const int ppos = (k0 & ~31) + 8 * ((k0 >> 2) & 3) + 4 * ((k0 >> 4) & 1) + (k0 & 3);
        unsigned rfA[16], rfB[16], rfC[16];
#define SCAN_ISSUE_F(rf, t_) do { if ((t_) < 68) { SCAN_ROWBASE(t_, _rb, _isctx) \
        const unsigned* _pf = (const unsigned*)((_isctx ? CF : F) + (_rb + (dir ? 63 - 16 * pw : 16 * pw)) * 128 + k0); \
        if (dir) { _Pragma("unroll") for (int j = 0; j < 16; ++j) rf[j] = _pf[-64 * j]; } else { _Pragma("unroll") for (int j = 0; j < 16; ++j) rf[j] = _pf[64 * j]; } } } while (0)
#define SCAN_PRODUCE(rf, t_, ACT, ISSUE) do { const int t = (t_); constexpr bool act = (ACT); \
            LAS unsigned char* buf = lds + (t & 1) * BUF_BYTES; \
            if (act) { float a0 = 1.f, a1 = 1.f; \
                _Pragma("unroll") for (int j = 0; j < 16; ++j) { const unsigned wv = rf[j]; a0 *= (float)__builtin_bit_cast(_Float16, (unsigned short)(wv & 0xffffu)); a1 *= (float)__builtin_bit_cast(_Float16, (unsigned short)(wv >> 16)); } \
                *(LAS f32x2*)(TT + pw * 128 + k0) = (f32x2){a0, a1}; } \
            LDS_BARRIER();     \
            if (act) { \
                float eo0 = 1.f, eo1 = 1.f, el0 = 1.f, el1 = 1.f; \
                _Pragma("unroll") for (int ww = 0; ww < 4; ++ww) { const f32x2 tv = *(const LAS f32x2*)(TT + ww * 128 + k0); if (ww < pw) { eo0 *= tv.x; eo1 *= tv.y; } el0 *= tv.x; el1 *= tv.y; } \
                if (pw == 0) *(LAS f32x2*)(buf + OFF_DEC + 4 * k0) = (f32x2){el0, el1}; \
                unsigned ke[16]; \
                _Pragma("unroll") for (int j = 0; j < 16; ++j) { const int i = 16 * pw + j; \
                    const unsigned wv = rf[j]; const float f0 = (float)__builtin_bit_cast(_Float16, (unsigned short)(wv & 0xffffu)), f1 = (float)__builtin_bit_cast(_Float16, (unsigned short)(wv >> 16)); \
                    eo0 *= f0; eo1 *= f1; const float e0 = eo0, e1 = eo1; \
                    const float kd0 = (1.0f - f0) * __builtin_amdgcn_rcpf(e0), kd1 = (1.0f - f1) * __builtin_amdgcn_rcpf(e1); \
                    ke[j] = cvt_pk_bf16(kd0 * el0, kd1 * el1); \
                    const unsigned qw = *(const LAS unsigned*)(QRAW + i * QD_STRIDE + 2 * k0); \
                    *(LAS unsigned*)(buf + i * QD_STRIDE + 2 * ppos) = cvt_pk_bf16(bf_lo(qw) * e0, bf_hi(qw) * e1);     \
                    *(LAS unsigned*)(KD + i * QD_STRIDE + 2 * ppos) = cvt_pk_bf16(kd0, kd1); } \
                { u32x4 a, bb; \
                  _Pragma("unroll") for (int q = 0; q < 2; ++q) { \
                    a.x = (ke[8 * q + 0] & 0xffffu) | (ke[8 * q + 1] << 16); a.y = (ke[8 * q + 2] & 0xffffu) | (ke[8 * q + 3] << 16); a.z = (ke[8 * q + 4] & 0xffffu) | (ke[8 * q + 5] << 16); a.w = (ke[8 * q + 6] & 0xffffu) | (ke[8 * q + 7] << 16); \
                    bb.x = (ke[8 * q + 0] >> 16) | (ke[8 * q + 1] & 0xffff0000u); bb.y = (ke[8 * q + 2] >> 16) | (ke[8 * q + 3] & 0xffff0000u); bb.z = (ke[8 * q + 4] >> 16) | (ke[8 * q + 5] & 0xffff0000u); bb.w = (ke[8 * q + 6] >> 16) | (ke[8 * q + 7] & 0xffff0000u); \
                    *(LAS u32x4*)(buf + OFF_KET + (k0 + 0) * KT_STRIDE + 32 * pw + 16 * q) = a; *(LAS u32x4*)(buf + OFF_KET + (k0 + 1) * KT_STRIDE + 32 * pw + 16 * q) = bb; } } \
                if (ISSUE) SCAN_ISSUE_F(rf, t + 3); \
            } \
            LDS_BARRIER();     \
            LDS_BARRIER();     \
        } while (0)
        SCAN_ISSUE_F(rfA, 0); SCAN_ISSUE_F(rfB, 1); SCAN_ISSUE_F(rfC, 2);
        for (int t3 = 0; t3 < 63; t3 += 3) {
            SCAN_PRODUCE(rfA, t3, true, true);
            SCAN_PRODUCE(rfB, t3 + 1, true, true);
            SCAN_PRODUCE(rfC, t3 + 2, true, true);
        }
        SCAN_PRODUCE(rfA, 63, true, true); SCAN_PRODUCE(rfB, 64, true, true); SCAN_PRODUCE(rfC, 65, true, false);
        SCAN_PRODUCE(rfA, 66, true, false); SCAN_PRODUCE(rfB, 67, true, false); SCAN_PRODUCE(rfC, 68, false, false);
        SCAN_PRODUCE(rfA, 69, false, false); SCAN_PRODUCE(rfB, 70, false, false); SCAN_PRODUCE(rfC, 71, false, false);
#undef SCAN_PRODUCE
#undef SCAN_ISSUE_F
    } else {
        f32x4 S[8];
#pragma unroll
        for (int tk = 0; tk < 8; ++tk) S[tk] = (f32x4){0.f, 0.f, 0.f, 0.f};
        const int k0 = 2 * lane, vp = lane & 31, vh = lane >> 5, chv = 64 * half + 2 * vp;
        unsigned rqA[16], rvA[8], rqB[16], rvB[8];
#define SCAN_ISSUE_QV(rq, rv, t_) do { if ((t_) < 68) { SCAN_ROWBASE(t_, _rb, _isctx) \
        const unsigned* _pq = (const unsigned*)(Q + (_rb + (dir ? 63 - 16 * w : 16 * w)) * 128 + k0); \
        const unsigned* _pv = (const unsigned*)((_isctx ? CV : V) + (_rb + (dir ? 63 - 16 * w - 8 * vh : 16 * w + 8 * vh)) * 128 + chv); \
        if (dir) { _Pragma("unroll") for (int j = 0; j < 16; ++j) rq[j] = _pq[-64 * j]; _Pragma("unroll") for (int j = 0; j < 8; ++j) rv[j] = _pv[-64 * j]; } \
        else     { _Pragma("unroll") for (int j = 0; j < 16; ++j) rq[j] = _pq[64 * j];  _Pragma("unroll") for (int j = 0; j < 8; ++j) rv[j] = _pv[64 * j]; } } } while (0)
#define SCAN_CONSUME(rq, rv, s_, RUN, LAT, NXT, ISSUE, PNEXT) do { const int s = (s_); constexpr bool run = (RUN), lat = (LAT), nxt = (NXT); \
            LAS unsigned char* buf = lds + (s & 1) * BUF_BYTES; \
            LAS unsigned char* nbuf = lds + ((s + 1) & 1) * BUF_BYTES; \
              \
            bf16x8 qfa[4][4]; \
            if (lat) { \
                _Pragma("unroll") for (int tt = 0; tt < 4; ++tt) \
                    _Pragma("unroll") for (int g = 0; g < 4; ++g) qfa[tt][g] = *(const LAS bf16x8*)(buf + (16 * tt + fr) * QD_STRIDE + 2 * (32 * g + 8 * fq)); \
            } \
            if (nxt) {     \
                _Pragma("unroll") for (int j = 0; j < 16; ++j) *(LAS unsigned*)(QRAW + (16 * w + j) * QD_STRIDE + 2 * k0) = rq[j]; \
                u32x4 a, bb; \
                a.x = (rv[0] & 0xffffu) | (rv[1] << 16); a.y = (rv[2] & 0xffffu) | (rv[3] << 16); a.z = (rv[4] & 0xffffu) | (rv[5] << 16); a.w = (rv[6] & 0xffffu) | (rv[7] << 16); \
                bb.x = (rv[0] >> 16) | (rv[1] & 0xffff0000u); bb.y = (rv[2] >> 16) | (rv[3] & 0xffff0000u); bb.z = (rv[4] >> 16) | (rv[5] & 0xffff0000u); bb.w = (rv[6] >> 16) | (rv[7] & 0xffff0000u); \
                *(LAS u32x4*)(nbuf + OFF_VT + (2 * vp + 0) * KT_STRIDE + 32 * w + 16 * vh) = a; *(LAS u32x4*)(nbuf + OFF_VT + (2 * vp + 1) * KT_STRIDE + 32 * w + 16 * vh) = bb; \
                if (ISSUE) SCAN_ISSUE_QV(rq, rv, s + 3); } \
            f32x4 o[4]; \
            _Pragma("unroll") for (int tt = 0; tt < 4; ++tt) o[tt] = (f32x4){0.f, 0.f, 0.f, 0.f}; \
            if (lat) {     \
                bf16x8 sf[4]; \
                _Pragma("unroll") for (int g = 0; g < 4; ++g) { u32x4 t4; t4.x = cvt_pk_bf16(S[2 * g][0], S[2 * g][1]); t4.y = cvt_pk_bf16(S[2 * g][2], S[2 * g][3]); t4.z = cvt_pk_bf16(S[2 * g + 1][0], S[2 * g + 1][1]); t4.w = cvt_pk_bf16(S[2 * g + 1][2], S[2 * g + 1][3]); \
                    sf[g] = __builtin_bit_cast(bf16x8, t4); } \
                LDS_WAIT(); \
                _Pragma("unroll") for (int tt = 0; tt < 4; ++tt) \
                    _Pragma("unroll") for (int g = 0; g < 4; ++g) o[tt] = __builtin_amdgcn_mfma_f32_16x16x32_bf16(sf[g], qfa[tt][g], o[tt], 0, 0, 0); \
            } \
            LDS_BARRIER();     \
            bf16x8 vf[2], pfa[4][2], kfa[4][2], kfb[4][2]; f32x4 d4a[4], d4b[4]; \
            if (run) { _Pragma("unroll") for (int z = 0; z < 2; ++z) vf[z] = *(const LAS bf16x8*)(buf + OFF_VT + (16 * w + fr) * KT_STRIDE + 2 * (32 * z + 8 * fq)); } \
            if (lat) { _Pragma("unroll") for (int tt = 0; tt < 4; ++tt) _Pragma("unroll") for (int z = 0; z < 2; ++z) pfa[tt][z] = *(const LAS bf16x8*)(buf + OFF_PM + (16 * tt + fr) * KT_STRIDE + 2 * (32 * z + 8 * fq)); } \
            LDS_WAIT(); \
            if (run) {     \
                _Pragma("unroll") for (int tk = 0; tk < 4; ++tk) { d4a[tk] = *(const LAS f32x4*)(buf + OFF_DEC + 4 * (16 * tk + 4 * fq)); \
                    _Pragma("unroll") for (int z = 0; z < 2; ++z) kfa[tk][z] = *(const LAS bf16x8*)(buf + OFF_KET + (16 * tk + fr) * KT_STRIDE + 2 * (32 * z + 8 * fq)); } } \
            if (lat) {     \
                SCAN_ROWBASE(s, rb, isctx_unused) \
                (void)isctx_unused; \
                _Pragma("unroll") for (int tt = 0; tt < 4; ++tt) { \
                    _Pragma("unroll") for (int z = 0; z < 2; ++z) o[tt] = __builtin_amdgcn_mfma_f32_16x16x32_bf16(vf[z], pfa[tt][z], o[tt], 0, 0, 0); } \
                _Pragma("unroll") for (int tt = 0; tt < 4; ++tt) { \
                    const int i = 16 * tt + fr; const size_t row = rb + (dir ? 63 - i : i); \
                    u32x2 wv; wv.x = cvt_pk_bf16(o[tt][0], o[tt][1]); wv.y = cvt_pk_bf16(o[tt][2], o[tt][3]); \
                    *(u32x2*)(O + row * 128 + 64 * half + 16 * w + 4 * fq) = wv; } \
            } \
            if (run) {     \
                LDS_WAIT(); \
                _Pragma("unroll") for (int tk = 0; tk < 4; ++tk) { d4b[tk] = *(const LAS f32x4*)(buf + OFF_DEC + 4 * (16 * (tk + 4) + 4 * fq)); \
                    _Pragma("unroll") for (int z = 0; z < 2; ++z) kfb[tk][z] = *(const LAS bf16x8*)(buf + OFF_KET + (16 * (tk + 4) + fr) * KT_STRIDE + 2 * (32 * z + 8 * fq)); } \
                _Pragma("unroll") for (int tk = 0; tk < 4; ++tk) { \
                    f32x4 a = S[tk] * d4a[tk]; \
                    _Pragma("unroll") for (int z = 0; z < 2; ++z) a = __builtin_amdgcn_mfma_f32_16x16x32_bf16(kfa[tk][z], vf[z], a, 0, 0, 0); \
                    S[tk] = a; } \
                LDS_WAIT(); \
                _Pragma("unroll") for (int tk = 0; tk < 4; ++tk) { \
                    f32x4 a = S[tk + 4] * d4b[tk]; \
                    _Pragma("unroll") for (int z = 0; z < 2; ++z) a = __builtin_amdgcn_mfma_f32_16x16x32_bf16(kfb[tk][z], vf[z], a, 0, 0, 0); \
                    S[tk + 4] = a; } \
            } \
            LDS_BARRIER();     \
            if (PNEXT) {     \
                const int tt = w; \
                bf16x8 qf[4], kfp[4][4]; \
                _Pragma("unroll") for (int g = 0; g < 4; ++g) qf[g] = *(const LAS bf16x8*)(nbuf + (16 * tt + fr) * QD_STRIDE + 2 * (32 * g + 8 * fq)); \
                _Pragma("unroll") for (int ts = 0; ts < 4; ++ts) \
                    _Pragma("unroll") for (int g = 0; g < 4; ++g) kfp[ts][g] = *(const LAS bf16x8*)(KD + (16 * ts + fr) * QD_STRIDE + 2 * (32 * g + 8 * fq)); \
                LDS_WAIT(); \
                _Pragma("unroll") for (int ts = 0; ts < 4; ++ts) { \
                    const int ii = 16 * tt + fr, ip0 = 16 * ts + 4 * fq; \
                    u32x2 wv = (u32x2){0u, 0u}; \
                    if (ts <= tt) { \
                        f32x4 pc = (f32x4){0.f, 0.f, 0.f, 0.f}; \
                        _Pragma("unroll") for (int g = 0; g < 4; ++g) pc = __builtin_amdgcn_mfma_f32_16x16x32_bf16(kfp[ts][g], qf[g], pc, 0, 0, 0); \
                        f32x4 pm; \
                        _Pragma("unroll") for (int j = 0; j < 4; ++j) pm[j] = (ip0 + j <= ii) ? pc[j] : 0.f; \
                        wv.x = cvt_pk_bf16(pm[0], pm[1]); wv.y = cvt_pk_bf16(pm[2], pm[3]); } \
                    *(LAS u32x2*)(nbuf + OFF_PM + ii * KT_STRIDE + 2 * ip0) = wv; } \
            } \
            LDS_BARRIER();     \
        } while (0)
        SCAN_ISSUE_QV(rqA, rvA, 0); SCAN_ISSUE_QV(rqB, rvB, 1);
        SCAN_CONSUME(rqA, rvA, -1, false, false, true, true, false);
        SCAN_CONSUME(rqB, rvB, 0, true, false, true, true, false); SCAN_CONSUME(rqA, rvA, 1, true, false, true, true, false);
        SCAN_CONSUME(rqB, rvB, 2, true, false, true, true, false); SCAN_CONSUME(rqA, rvA, 3, true, false, true, true, true);
        for (int s2 = 4; s2 < 64; s2 += 2) {
            SCAN_CONSUME(rqB, rvB, s2, true, true, true, true, true);
            SCAN_CONSUME(rqA, rvA, s2 + 1, true, true, true, true, true);
        }
        SCAN_CONSUME(rqB, rvB, 64, true, true, true, true, true); SCAN_CONSUME(rqA, rvA, 65, true, true, true, false, true);
        SCAN_CONSUME(rqB, rvB, 66, true, true, true, false, true); SCAN_CONSUME(rqA, rvA, 67, true, true, false, false, false);
        SCAN_CONSUME(rqB, rvB, 68, false, false, false, false, false); SCAN_CONSUME(rqA, rvA, 69, false, false, false, false, false); SCAN_CONSUME(rqB, rvB, 70, false, false, false, false, false);
#undef SCAN_CONSUME
#undef SCAN_ISSUE_QV
    }
#undef SCAN_ROWBASE
}
__device__ __forceinline__ void phase_gmlp(const Params& p, LAS unsigned char* lds, int unit) {
    const int tid = threadIdx.x, lane = tid & 63, w = __builtin_amdgcn_readfirstlane(tid >> 6), fr = lane & 15, fq = lane >> 4;
    unsigned char* ws = p.ws;
    const bf16_t* U = (const bf16_t*)(ws + WS_Q + 5 * PROJ_STRIDE); const bf16_t* VG = (const bf16_t*)(ws + WS_Q + 6 * PROJ_STRIDE);
    bf16_t* A2 = (bf16_t*)(ws + WS_HB);
    const float* ln_g = p.in[13]; const float* ln_b = p.in[14]; const float* w_s = p.in[15]; const float* b_s = p.in[16];
    constexpr int TS = 272;
    LAS unsigned char* VNT = lds;
    LAS unsigned char* WS_ = lds + 128 * TS;
    LAS float* MU = (LAS float*)(lds + 2 * 128 * TS); LAS float* RS = MU + 128;
    const size_t row0 = (size_t)unit * 128;
    __syncthreads();
#pragma unroll
    for (int hf = 0; hf < 2; ++hf) {
        u32x4 xa[8][2];
#pragma unroll
        for (int rr = 0; rr < 8; ++rr) { const u32x4* src = (const u32x4*)(VG + (row0 + 16 * w + 8 * hf + rr) * 1024 + 16 * lane); xa[rr][0] = src[0]; xa[rr][1] = src[1]; }
        float sm[8], sq[8];
#pragma unroll
        for (int rr = 0; rr < 8; ++rr) { float s1 = 0.f, s2 = 0.f;
#pragma unroll
            for (int q = 0; q < 2; ++q) { const unsigned ww[4] = {xa[rr][q].x, xa[rr][q].y, xa[rr][q].z, xa[rr][q].w};
#pragma unroll
                for (int j = 0; j < 4; ++j) { const float a = bf_lo(ww[j]), c = bf_hi(ww[j]); s1 += a + c; s2 += a * a + c * c; } }
            sm[rr] = s1; sq[rr] = s2; }
#pragma unroll
        for (int o = 1; o < 64; o <<= 1) {
#pragma unroll
            for (int rr = 0; rr < 8; ++rr) { sm[rr] += __shfl_xor(sm[rr], o); sq[rr] += __shfl_xor(sq[rr], o); } }
        if (lane < 8) { float m = 0.f, q2 = 0.f;
#pragma unroll
            for (int rr = 0; rr < 8; ++rr) { m = (lane == rr) ? sm[rr] : m; q2 = (lane == rr) ? sq[rr] : q2; }
            const float mean = m * (1.0f / 1024.0f); const float var = fmaxf(q2 * (1.0f / 1024.0f) - mean * mean, 0.f);
            MU[16 * w + 8 * hf + lane] = mean; RS[16 * w + 8 * hf + lane] = 1.0f / sqrtf(var + EPS); }
    }
    unsigned vr[16]; f32x4 wr4[8];
#define GMLP_LOAD(g_) do { const int _d0 = 2 * lane; \
        _Pragma("unroll") for (int j = 0; j < 16; ++j) vr[j] = *(const unsigned*)(VG + (row0 + 16 * w + j) * 1024 + (g_) * 128 + _d0); \
        const f32x4* _src = (const f32x4*)(w_s + ((size_t)(g_) * 128 + (tid >> 2)) * 128 + (tid & 3) * 32); \
        _Pragma("unroll") for (int q4 = 0; q4 < 8; ++q4) wr4[q4] = _src[q4]; } while (0)
    GMLP_LOAD(0);
    __syncthreads();
#define GMLP_GROUP(g_, PREFETCH) do { const int g = (g_); \
        { const int d0 = 2 * lane; const float g0 = ln_g[g * 128 + d0], g1 = ln_g[g * 128 + d0 + 1], b0 = ln_b[g * 128 + d0], b1 = ln_b[g * 128 + d0 + 1]; \
          unsigned pk[16]; \
        _Pragma("unroll") \
          for (int j = 0; j < 16; ++j) { const int sidx = 16 * w + j; const unsigned wv = vr[j]; const float mu = MU[sidx], rs = RS[sidx]; \
              pk[j] = cvt_pk_bf16((bf_lo(wv) - mu) * rs * g0 + b0, (bf_hi(wv) - mu) * rs * g1 + b1); } \
          u32x4 a, bb, c2, d2; \
          a.x = (pk[0] & 0xffffu) | (pk[1] << 16); a.y = (pk[2] & 0xffffu) | (pk[3] << 16); a.z = (pk[4] & 0xffffu) | (pk[5] << 16); a.w = (pk[6] & 0xffffu) | (pk[7] << 16); \
          bb.x = (pk[8] & 0xffffu) | (pk[9] << 16); bb.y = (pk[10] & 0xffffu) | (pk[11] << 16); bb.z = (pk[12] & 0xffffu) | (pk[13] << 16); bb.w = (pk[14] & 0xffffu) | (pk[15] << 16); \
          c2.x = (pk[0] >> 16) | (pk[1] & 0xffff0000u); c2.y = (pk[2] >> 16) | (pk[3] & 0xffff0000u); c2.z = (pk[4] >> 16) | (pk[5] & 0xffff0000u); c2.w = (pk[6] >> 16) | (pk[7] & 0xffff0000u); \
          d2.x = (pk[8] >> 16) | (pk[9] & 0xffff0000u); d2.y = (pk[10] >> 16) | (pk[11] & 0xffff0000u); d2.z = (pk[12] >> 16) | (pk[13] & 0xffff0000u); d2.w = (pk[14] >> 16) | (pk[15] & 0xffff0000u); \
          *(LAS u32x4*)(VNT + (d0 + 0) * TS + 32 * w) = a; *(LAS u32x4*)(VNT + (d0 + 0) * TS + 32 * w + 16) = bb; \
          *(LAS u32x4*)(VNT + (d0 + 1) * TS + 32 * w) = c2; *(LAS u32x4*)(VNT + (d0 + 1) * TS + 32 * w + 16) = d2; } \
        { const int t = tid >> 2, s0 = (tid & 3) * 32; \
        _Pragma("unroll") \
          for (int q4 = 0; q4 < 4; ++q4) { const f32x4 x0 = wr4[2 * q4], x1 = wr4[2 * q4 + 1]; u32x4 o; o.x = cvt_pk_bf16(x0.x, x0.y); o.y = cvt_pk_bf16(x0.z, x0.w); o.z = cvt_pk_bf16(x1.x, x1.y); o.w = cvt_pk_bf16(x1.z, x1.w); \
              *(LAS u32x4*)(WS_ + t * TS + 2 * s0 + 16 * q4) = o; } } \
        u32x2 uv[8]; float bsv[8]; \
        _Pragma("unroll") \
        for (int tt = 0; tt < 8; ++tt) { const int t = 16 * tt + fr; uv[tt] = *(const u32x2*)(U + (row0 + t) * 1024 + g * 128 + 16 * w + 4 * fq); bsv[tt] = b_s[g * 128 + t]; } \
        if (PREFETCH) GMLP_LOAD(g + 1); \
        LDS_BARRIER(); \
        bf16x8 af[4]; \
        _Pragma("unroll") \
        for (int ks = 0; ks < 4; ++ks) af[ks] = *(const LAS bf16x8*)(VNT + (16 * w + fr) * TS + 2 * (32 * ks + 8 * fq)); \
        _Pragma("unroll") \
        for (int tt = 0; tt < 8; ++tt) { \
            f32x4 a = (f32x4){0.f, 0.f, 0.f, 0.f}; \
        _Pragma("unroll") \
            for (int ks = 0; ks < 4; ++ks) { const bf16x8 bfr = *(const LAS bf16x8*)(WS_ + (16 * tt + fr) * TS + 2 * (32 * ks + 8 * fq)); a = __builtin_amdgcn_mfma_f32_16x16x32_bf16(af[ks], bfr, a, 0, 0, 0); } \
            const int t = 16 * tt + fr; const float bs = bsv[tt]; \
            u32x2 o; o.x = cvt_pk_bf16(bf_lo(uv[tt].x) * (a[0] + bs), bf_hi(uv[tt].x) * (a[1] + bs)); o.y = cvt_pk_bf16(bf_lo(uv[tt].y) * (a[2] + bs), bf_hi(uv[tt].y) * (a[3] + bs)); \
            *(u32x2*)(A2 + (row0 + t) * 2048 + 1024 + g * 128 + 16 * w + 4 * fq) = o; \
        } \
        LDS_BARRIER(); \
    } while (0)
    for (int gg = 0; gg < 7; ++gg) GMLP_GROUP(gg, true);
    GMLP_GROUP(7, false);
#undef GMLP_GROUP
#undef GMLP_LOAD
}
__device__ __forceinline__ void phase_hgrn_out(const Params& p) {
    const int lane = threadIdx.x & 63, wave = __builtin_amdgcn_readfirstlane(threadIdx.x >> 6);
    const int gw = blockIdx.x * NWAVES + wave, NGW = gridDim.x * NWAVES;
    unsigned char* ws = p.ws;
    const bf16_t* OF = (const bf16_t*)(ws + WS_OF); const bf16_t* OB = (const bf16_t*)(ws + WS_OB); const bf16_t* G = (const bf16_t*)(ws + WS_Q + 4 * PROJ_STRIDE);
    bf16_t* A2 = (bf16_t*)(ws + WS_HB); const float* ng = p.in[12];
    f32x4 gn[4];
#pragma unroll
    for (int j = 0; j < 4; ++j) gn[j] = ((const f32x4*)(ng + 16 * lane))[j];
    const int n = gw < M ? (M - gw + NGW - 1) / NGW : 0;
    u32x4 fa[2], ba[2], ga[2], fb[2], bb[2], gb[2];
#define HO_LOAD(f_, b_, g_, r_) do { const int _r = (r_) < M ? (r_) : M - 1; \
        const size_t _ohm = ((size_t)((_r / SEQ) * 8 + (lane >> 3)) * SEQ + (_r % SEQ)) * 128 + 16 * (lane & 7);     \
        const u32x4* _pf = (const u32x4*)(OF + _ohm); const u32x4* _pb = (const u32x4*)(OB + _ohm); const u32x4* _pg = (const u32x4*)(G + (size_t)_r * 1024 + 16 * lane); \
        f_[0] = _pf[0]; f_[1] = _pf[1]; b_[0] = _pb[0]; b_[1] = _pb[1]; g_[0] = _pg[0]; g_[1] = _pg[1]; } while (0)
#define HO_STORE(f_, b_, g_, r_) do { const int r = (r_); float o[16]; float ss = 0.f; unsigned gg[8]; \
        _Pragma("unroll") for (int q = 0; q < 2; ++q) { const unsigned aw[4] = {f_[q].x, f_[q].y, f_[q].z, f_[q].w}, bw[4] = {b_[q].x, b_[q].y, b_[q].z, b_[q].w}, gw4[4] = {g_[q].x, g_[q].y, g_[q].z, g_[q].w}; \
            _Pragma("unroll") for (int j = 0; j < 4; ++j) { o[8 * q + 2 * j] = bf_lo(aw[j]) + bf_lo(bw[j]); o[8 * q + 2 * j + 1] = bf_hi(aw[j]) + bf_hi(bw[j]); gg[4 * q + j] = gw4[j]; } } \
        _Pragma("unroll") for (int j = 0; j < 16; ++j) ss += o[j] * o[j]; \
        ss += __shfl_xor(ss, 1); ss += __shfl_xor(ss, 2); ss += __shfl_xor(ss, 4); \
        const float rinv = 1.0f / sqrtf(ss * (1.0f / 128.0f) + EPS); \
        unsigned ow[8]; \
        _Pragma("unroll") for (int j = 0; j < 8; ++j) { const float g0 = gn[j >> 1][(2 * j) & 3], g1 = gn[j >> 1][(2 * j + 1) & 3]; \
            ow[j] = cvt_pk_bf16(o[2 * j] * rinv * g0 * bf_lo(gg[j]), o[2 * j + 1] * rinv * g1 * bf_hi(gg[j])); } \
        u32x4* dst = (u32x4*)(A2 + (size_t)r * 2048 + 16 * lane); \
        dst[0] = (u32x4){ow[0], ow[1], ow[2], ow[3]}; dst[1] = (u32x4){ow[4], ow[5], ow[6], ow[7]}; } while (0)
    HO_LOAD(fa, ba, ga, gw);
    int k = 0;
    for (; k + 2 < n; k += 2) {
        HO_LOAD(fb, bb, gb, gw + (k + 1) * NGW); HO_STORE(fa, ba, ga, gw + k * NGW);
        HO_LOAD(fa, ba, ga, gw + (k + 2) * NGW); HO_STORE(fb, bb, gb, gw + (k + 1) * NGW);
    }
    HO_LOAD(fb, bb, gb, gw + (k + 1) * NGW);
    if (k < n) HO_STORE(fa, ba, ga, gw + k * NGW);
    if (k + 1 < n) HO_STORE(fb, bb, gb, gw + (k + 1) * NGW);
#undef HO_LOAD
#undef HO_STORE
}
typedef _Float16 f16x8 __attribute__((ext_vector_type(8)));
typedef _Float16 f16x2 __attribute__((ext_vector_type(2)));
__device__ __forceinline__ unsigned cvt_pk_f16(float lo, float hi) { const f32x2 v = {lo, hi}; return __builtin_bit_cast(unsigned, __builtin_convertvector(v, f16x2)); }
__device__ __forceinline__ void phase_router(const Params& p, LAS unsigned char* lds, int l) {
    const int tid = threadIdx.x, lane = tid & 63, w = __builtin_amdgcn_readfirstlane(tid >> 6), fr = lane & 15, fq = lane >> 4;
    unsigned char* ws = p.ws;
    const bf16_t* X = (const bf16_t*)(ws + WS_XB); bf16_t* HB = (bf16_t*)(ws + WS_HB);
    const float* MOD = (const float*)(ws + WS_MOD) + (size_t)l * 9 * 12288;
    const _Float16* RW = (const _Float16*)(ws + WS_RW) + (size_t)l * 48 * 2048;
    const float* RB = (const float*)(ws + WS_RB) + l * 48; const float* gnorm = p.in[7] + (size_t)l * D;
    int* ASG_E = (int*)(ws + RT_ASG_E); int* ASG_R = (int*)(ws + RT_ASG_R); float* ASG_W = (float*)(ws + RT_ASG_W); int* CNT = (int*)(ws + RT_CNT);
    LAS float* GS = (LAS float*)lds;
    LAS float* SH = GS + 2048;
    LAS float* SSQ = SH + 2048;
    LAS float* PL = SSQ + 256;
    LAS float* LG = PL + 2 * 8 * 16 * 48;
    LAS int* T_E = (LAS int*)(LG + 128 * 48);
    LAS float* T_W = (LAS float*)(T_E + 256);
    LAS int* T_R = (LAS int*)(T_W + 256);
    f16x8 bw[8][3];
#pragma unroll
    for (int ks = 0; ks < 8; ++ks)
#pragma unroll
        for (int ct = 0; ct < 3; ++ct) bw[ks][ct] = *(const f16x8*)(RW + (size_t)(16 * ct + fr) * 2048 + 256 * w + 32 * ks + 8 * fq);
    for (int tile = blockIdx.x; tile < M / 128; tile += gridDim.x) {
        const int b = (tile * 128) / SEQ; const float* md = MOD + (size_t)b * 12288;
        __syncthreads();
        for (int k = tid; k < 2048; k += NTHREADS) { GS[k] = gnorm[k] * (1.0f + md[4 * 2048 + k]); SH[k] = md[3 * 2048 + k]; }
        u32x4 xw[8];
#define ROUTER_LOAD(grp_) do { const bf16_t* _src = X + ((size_t)tile * 128 + (grp_) * 16 + fr) * D + 256 * w + 8 * fq; \
        _Pragma("unroll") for (int ks = 0; ks < 8; ++ks) xw[ks] = *(const u32x4*)(_src + 32 * ks); } while (0)
        ROUTER_LOAD(0);
        __syncthreads();
#define ROUTER_GROUP(grp_, PREFETCH) do { const int grp = (grp_); \
            const size_t rbase = (size_t)tile * 128 + grp * 16; \
            LAS float* ssq = SSQ + (grp & 1) * 128; LAS float* pl = PL + (grp & 1) * (8 * 16 * 48); \
            float ss = 0.f; \
            _Pragma("unroll") \
            for (int ks = 0; ks < 8; ++ks) { const u32x4 t4 = xw[ks]; const unsigned tw[4] = {t4.x, t4.y, t4.z, t4.w}; \
            _Pragma("unroll") \
                for (int q = 0; q < 4; ++q) { const float a = bf_lo(tw[q]), c = bf_hi(tw[q]); ss += a * a + c * c; } } \
            ss += __shfl_xor(ss, 16); ss += __shfl_xor(ss, 32); \
            if (fq == 0) ssq[w * 16 + fr] = ss; \
            LDS_BARRIER(); \
            float tot = 0.f; \
            _Pragma("unroll") \
            for (int ww = 0; ww < 8; ++ww) tot += ssq[ww * 16 + fr]; \
            const float rinv = 1.0f / sqrtf(tot * (1.0f / D) + EPS); \
            f32x4 acc[3]; \
            _Pragma("unroll") \
            for (int ct = 0; ct < 3; ++ct) acc[ct] = (f32x4){0.f, 0.f, 0.f, 0.f}; \
            _Pragma("unroll") \
            for (int ks = 0; ks < 8; ++ks) { \
                const int kk = 256 * w + 32 * ks + 8 * fq; \
                float hv[8]; \
            _Pragma("unroll") \
                for (int q = 0; q < 2; ++q) { const f32x4 gs = *(const LAS f32x4*)(GS + kk + 4 * q), sh = *(const LAS f32x4*)(SH + kk + 4 * q); \
                    const unsigned x01 = q ? xw[ks].z : xw[ks].x, x23 = q ? xw[ks].w : xw[ks].y; const f32x4 xq = (f32x4){bf_lo(x01), bf_hi(x01), bf_lo(x23), bf_hi(x23)}; \
                    const f32x4 hh = xq * rinv * gs + sh; \
                    hv[4 * q] = hh.x; hv[4 * q + 1] = hh.y; hv[4 * q + 2] = hh.z; hv[4 * q + 3] = hh.w; } \
                u32x4 hi, hf; \
                hi.x = cvt_pk_bf16(hv[0], hv[1]); hi.y = cvt_pk_bf16(hv[2], hv[3]); hi.z = cvt_pk_bf16(hv[4], hv[5]); hi.w = cvt_pk_bf16(hv[6], hv[7]); \
                hf.x = cvt_pk_f16(hv[0], hv[1]); hf.y = cvt_pk_f16(hv[2], hv[3]); hf.z = cvt_pk_f16(hv[4], hv[5]); hf.w = cvt_pk_f16(hv[6], hv[7]); \
                *(u32x4*)(HB + (rbase + fr) * D + kk) = hi; \
                const f16x8 ah = __builtin_bit_cast(f16x8, hf); \
            _Pragma("unroll") \
                for (int ct = 0; ct < 3; ++ct) acc[ct] = __builtin_amdgcn_mfma_f32_16x16x32_f16(ah, bw[ks][ct], acc[ct], 0, 0, 0); \
                asm volatile("" ::: "memory"); \
            } \
            if (PREFETCH) ROUTER_LOAD(grp + 1);   \
            _Pragma("unroll") \
            for (int ct = 0; ct < 3; ++ct) \
            _Pragma("unroll") \
                for (int j = 0; j < 4; ++j) pl[(w * 16 + 4 * fq + j) * 48 + 16 * ct + fr] = acc[ct][j]; \
            LDS_BARRIER(); \
            for (int idx = tid; idx < 16 * 48; idx += NTHREADS) { float sred = 0.f; \
            _Pragma("unroll") \
                for (int ww = 0; ww < 8; ++ww) sred += pl[ww * 768 + idx]; \
                LG[grp * 768 + idx] = sred; } \
        } while (0)
        for (int gq = 0; gq < 7; ++gq) ROUTER_GROUP(gq, true);
        ROUTER_GROUP(7, false);
#undef ROUTER_GROUP
#undef ROUTER_LOAD
        __syncthreads();
        if (tid < 128) {
            float lg[4];
#pragma unroll
            for (int c2 = 0; c2 < 4; ++c2) lg[c2] = RB[c2] + LG[tid * 48 + c2];
            int gi = 0; float gm = lg[0];
#pragma unroll
            for (int q = 1; q < 4; ++q) if (lg[q] > gm) { gm = lg[q]; gi = q; }
            float gsum = 0.f;
#pragma unroll
            for (int q = 0; q < 4; ++q) gsum += __expf(lg[q] - gm);
            const float ptop = 1.0f / gsum;
            float le[8];
#pragma unroll
            for (int q = 0; q < 8; ++q) le[q] = RB[4 + 8 * gi + q] + LG[tid * 48 + 4 + 8 * gi + q];
            int i0 = 0; float m0 = le[0];
#pragma unroll
            for (int q = 1; q < 8; ++q) if (le[q] > m0) { m0 = le[q]; i0 = q; }
            int i1 = -1; float m1 = -3.0e38f;
#pragma unroll
            for (int q = 0; q < 8; ++q) if (q != i0 && le[q] > m1) { m1 = le[q]; i1 = q; }
            if (i1 < 0) { i1 = (i0 + 1) & 7; m1 = m0; }
            float e1 = __expf(m1 - m0);
            if (!(e1 <= 1.0f)) e1 = 1.0f;
            const float w0 = ptop / (1.0f + e1), w1 = ptop * e1 / (1.0f + e1);
            const int a0 = tid * 2;
            T_E[a0] = gi * 8 + i0; T_E[a0 + 1] = gi * 8 + i1; T_W[a0] = w0; T_W[a0 + 1] = w1;
        }
        __syncthreads();
        if (tid < 32) { int cnt = 0; for (int a = 0; a < 256; ++a) { if (T_E[a] == tid) { T_R[a] = cnt; ++cnt; } } CNT[tile * 32 + tid] = cnt; }
        __syncthreads();
        if (tid < 256) { ASG_E[tile * 256 + tid] = T_E[tid]; ASG_R[tile * 256 + tid] = T_R[tid]; ASG_W[tile * 256 + tid] = T_W[tid]; }
    }
}
__device__ __forceinline__ void moe_tables(const Params& p, LAS int* OFFS, LAS int* TOT, LAS int* TILE_E, LAS int* PART) {
    const int tid = threadIdx.x; const int* CNT = (const int*)(p.ws + RT_CNT); const int e = tid & 31, part = tid >> 5;
    int v[16];
#pragma unroll
    for (int j = 0; j < 16; ++j) v[j] = CNT[(part * 16 + j) * 32 + e];
    int sp = 0;
#pragma unroll
    for (int j = 0; j < 16; ++j) sp += v[j];
    PART[part * 32 + e] = sp;
    __syncthreads();
    if (tid < 32) { int t = 0;
#pragma unroll
        for (int q = 0; q < 16; ++q) t += PART[q * 32 + tid];
        TOT[tid] = t; }
    __syncthreads();
    if (tid == 0) { int o = 0; for (int ee = 0; ee < 32; ++ee) { OFFS[ee] = o; const int pad = (TOT[ee] + 255) & ~255; for (int t = o / 256; t < (o + pad) / 256; ++t) TILE_E[t] = ee; o += pad; } OFFS[32] = o; }
    __syncthreads();
}
__device__ __forceinline__ void phase_dispatch(const Params& p, LAS unsigned char* lds) {
    const int tid = threadIdx.x; unsigned char* ws = p.ws;
    const int* CNT = (const int*)(ws + RT_CNT); const int* ASG_E = (const int*)(ws + RT_ASG_E); const int* ASG_R = (const int*)(ws + RT_ASG_R); const float* ASG_W = (const float*)(ws + RT_ASG_W);
    int* POS = (int*)(ws + RT_POS); int* BUF_TOK = (int*)(ws + RT_BUF_TOK); float* BUF_W = (float*)(ws + RT_BUF_W);
    LAS int* OFFS = (LAS int*)lds; LAS int* TOT = OFFS + 64; LAS int* TILE_E = TOT + 64; LAS int* BASE = TILE_E + 320; LAS int* PART = BASE + 64;
    moe_tables(p, OFFS, TOT, TILE_E, PART);
    for (int tile = blockIdx.x; tile < M / 128; tile += gridDim.x) {
        __syncthreads();
        if (tid < 32) { const int qb = tile >> 4; int sb = OFFS[tid];
            for (int q = 0; q < qb; ++q) sb += PART[q * 32 + tid];
            int v[16];
#pragma unroll
            for (int j = 0; j < 16; ++j) v[j] = (16 * qb + j < tile) ? CNT[(16 * qb + j) * 32 + tid] : 0;
#pragma unroll
            for (int j = 0; j < 16; ++j) sb += v[j];
            BASE[tid] = sb; }
        __syncthreads();
        if (tid < 256) { const int a = tile * 256 + tid; const int e = ASG_E[a]; const int pos = BASE[e] + ASG_R[a]; POS[a] = pos; BUF_TOK[pos] = tile * 128 + (tid >> 1); BUF_W[pos] = ASG_W[a]; }
    }
    if (blockIdx.x < 32) { const int e = blockIdx.x; const int lo = OFFS[e] + TOT[e], hi = OFFS[e + 1]; for (int r = lo + tid; r < hi; r += NTHREADS) { BUF_TOK[r] = 0; BUF_W[r] = 0.f; } }
}
__device__ __forceinline__ void phase_moe_combine(const Params& p, LAS unsigned char* lds, int l, bool final_norm) {
    const int tid = threadIdx.x, lane = tid & 63, wave = __builtin_amdgcn_readfirstlane(tid >> 6);
    const int gw = blockIdx.x * NWAVES + wave, NGW = gridDim.x * NWAVES;
    unsigned char* ws = p.ws; bf16_t* XB = (bf16_t*)(ws + WS_XB); const bf16_t* Y = (const bf16_t*)(ws + WS_Y); const int* POS = (const int*)(ws + RT_POS);
    const float* MOD = (const float*)(ws + WS_MOD); bf16_t* HB = (bf16_t*)(ws + WS_HB);
    const int RPW = (M + NGW - 1) / NGW;
    const int rwg = blockIdx.x * NWAVES * RPW; const int b = (rwg < M ? rwg : 0) / SEQ;
    LAS float* GATE = (LAS float*)lds; LAS float* GS = GATE + 2048; LAS float* SH = GS + 2048;
    __syncthreads();
    for (int k = tid; k < 2048; k += NTHREADS) {
        GATE[k] = MOD[(size_t)(l * 9 + b) * 12288 + 5 * 2048 + k];
        if (!final_norm) { const float* md = MOD + (size_t)((l + 1) * 9 + b) * 12288; GS[k] = p.in[6][(size_t)(l + 1) * D + k] * (1.0f + md[2048 + k]); SH[k] = md[k]; }
        else { GS[k] = p.in[8][k]; SH[k] = 0.f; }
    }
    __syncthreads();
    const int r0 = gw * RPW; const int n = r0 < M ? ((M - r0) < RPW ? (M - r0) : RPW) : 0;
    u32x2 xa[8], ya0[8], ya1[8], xb[8], yb0[8], yb1[8];
#define MC_LOAD(xw, y0, y1, r_) do { const int _r = (r_) < M ? (r_) : M - 1; const int _p0 = POS[2 * _r], _p1 = POS[2 * _r + 1]; \
        const u32x2* _y0 = (const u32x2*)(Y + (size_t)_p0 * D); const u32x2* _y1 = (const u32x2*)(Y + (size_t)_p1 * D); const u32x2* _xr = (const u32x2*)(XB + (size_t)_r * D); \
        _Pragma("unroll") for (int j = 0; j < 8; ++j) { xw[j] = _xr[lane + 64 * j]; y0[j] = _y0[lane + 64 * j]; y1[j] = _y1[lane + 64 * j]; } } while (0)
#define MC_STORE(xw, y0, y1, r_) do { const int r = (r_); f32x4 v[8]; float sq = 0.f; \
        _Pragma("unroll") for (int j = 0; j < 8; ++j) { const u32x2 a = y0[j], c = y1[j]; f32x4 f; f.x = bf_lo(a.x) + bf_lo(c.x); f.y = bf_hi(a.x) + bf_hi(c.x); f.z = bf_lo(a.y) + bf_lo(c.y); f.w = bf_hi(a.y) + bf_hi(c.y); \
            const f32x4 x = (f32x4){bf_lo(xw[j].x), bf_hi(xw[j].x), bf_lo(xw[j].y), bf_hi(xw[j].y)}; v[j] = x + *(const LAS f32x4*)(GATE + 4 * (lane + 64 * j)) * f; } \
        if (!final_norm) { u32x2* xr = (u32x2*)(XB + (size_t)r * D); \
            _Pragma("unroll") for (int j = 0; j < 8; ++j) { u32x2 o; o.x = cvt_pk_bf16(v[j].x, v[j].y); o.y = cvt_pk_bf16(v[j].z, v[j].w); xr[lane + 64 * j] = o; \
                v[j] = (f32x4){bf_lo(o.x), bf_hi(o.x), bf_lo(o.y), bf_hi(o.y)}; } }     \
        _Pragma("unroll") for (int j = 0; j < 8; ++j) sq += (v[j].x * v[j].x + v[j].y * v[j].y) + (v[j].z * v[j].z + v[j].w * v[j].w); \
        sq = wave_sum(sq); const float rinv = 1.0f / sqrtf(sq * (1.0f / D) + EPS); \
        if (!final_norm) { \
            _Pragma("unroll") for (int j = 0; j < 8; ++j) { const f32x4 h = v[j] * rinv * *(const LAS f32x4*)(GS + 4 * (lane + 64 * j)) + *(const LAS f32x4*)(SH + 4 * (lane + 64 * j)); \
                u32x2 w2; w2.x = cvt_pk_bf16(h.x, h.y); w2.y = cvt_pk_bf16(h.z, h.w); ((u32x2*)(HB + (size_t)r * D))[lane + 64 * j] = w2; } \
        } else { \
            _Pragma("unroll") for (int j = 0; j < 8; ++j) ((f32x4*)(p.out + (size_t)r * D))[lane + 64 * j] = v[j] * rinv * *(const LAS f32x4*)(GS + 4 * (lane + 64 * j)); } } while (0)
    if (n > 0) {
        MC_LOAD(xa, ya0, ya1, r0);
        int k = 0;
        for (; k + 2 < n; k += 2) {
            MC_LOAD(xb, yb0, yb1, r0 + k + 1); MC_STORE(xa, ya0, ya1, r0 + k);
            MC_LOAD(xa, ya0, ya1, r0 + k + 2); MC_STORE(xb, yb0, yb1, r0 + k + 1);
        }
        MC_LOAD(xb, yb0, yb1, r0 + k + 1);
        if (k < n) MC_STORE(xa, ya0, ya1, r0 + k);
        if (k + 1 < n) MC_STORE(xb, yb0, yb1, r0 + k + 1);
    }
#undef MC_LOAD
#undef MC_STORE
}
__device__ __forceinline__ void phase_conv(const Params& p) {
    const int lane = threadIdx.x & 63, wave = __builtin_amdgcn_readfirstlane(threadIdx.x >> 6);
    const int gw = blockIdx.x * NWAVES + wave, NGW = gridDim.x * NWAVES;
    unsigned char* ws = p.ws; const bf16_t* Z = (const bf16_t*)(ws + WS_P1); const bf16_t* BG = (const bf16_t*)(ws + WS_P1 + P1_STRIDE);
    bf16_t* A2 = (bf16_t*)(ws + WS_HB); const float* cw = p.in[18];
    for (int it = gw; it < (M / 64) * 4; it += NGW) {
        const int grow = it >> 2, cb = it & 3; const int c0 = cb * 512 + lane * 8; const size_t r0 = (size_t)grow * 64;
        float w0[8], w1[8], w2[8];
#pragma unroll
        for (int j = 0; j < 8; ++j) { w0[j] = cw[c0 + j]; w1[j] = cw[2048 + c0 + j]; w2[j] = cw[4096 + c0 + j]; }
        float zp[8], zc[8];
#pragma unroll
        for (int j = 0; j < 8; ++j) zp[j] = 0.f;
        { const u32x4 z4 = *(const u32x4*)(Z + r0 * D + c0); const unsigned zw[4] = {z4.x, z4.y, z4.z, z4.w};
#pragma unroll
          for (int j = 0; j < 4; ++j) { zc[2 * j] = bf_lo(zw[j]); zc[2 * j + 1] = bf_hi(zw[j]); } }
        u32x4 zn = *(const u32x4*)(Z + (r0 + 1) * D + c0), bgc = *(const u32x4*)(BG + r0 * D + c0);
#pragma unroll 4
        for (int i = 0; i < 64; ++i) {
            const u32x4 znn = *(const u32x4*)(Z + (r0 + (i + 2 < 64 ? i + 2 : 63)) * D + c0), bgn = *(const u32x4*)(BG + (r0 + (i + 1 < 64 ? i + 1 : 63)) * D + c0);
            const unsigned zw[4] = {zn.x, zn.y, zn.z, zn.w}, bw[4] = {bgc.x, bgc.y, bgc.z, bgc.w};
            float znf[8];
#pragma unroll
            for (int j = 0; j < 4; ++j) { znf[2 * j] = (i < 63) ? bf_lo(zw[j]) : 0.f; znf[2 * j + 1] = (i < 63) ? bf_hi(zw[j]) : 0.f; }
            unsigned o[4];
#pragma unroll
            for (int j = 0; j < 4; ++j) { const float y0 = w0[2 * j] * zp[2 * j] + w1[2 * j] * zc[2 * j] + w2[2 * j] * znf[2 * j], y1 = w0[2 * j + 1] * zp[2 * j + 1] + w1[2 * j + 1] * zc[2 * j + 1] + w2[2 * j + 1] * znf[2 * j + 1];
                o[j] = cvt_pk_bf16(bf_lo(bw[j]) * y0, bf_hi(bw[j]) * y1); }
            *(u32x4*)(A2 + (r0 + i) * D + c0) = (u32x4){o[0], o[1], o[2], o[3]};
#pragma unroll
            for (int j = 0; j < 8; ++j) { zp[j] = zc[j]; zc[j] = znf[j]; }
            zn = znn; bgc = bgn;
        }
    }
}

constexpr int NPHASES = 20;
__global__ void __launch_bounds__(NTHREADS, 2) fwd_kernel(Params p) {
    extern __shared__ __attribute__((aligned(16))) unsigned char lds_raw[];
    LAS unsigned char* lds = (LAS unsigned char*)lds_raw;
    volatile LAS unsigned* MISC = (volatile LAS unsigned*)(lds + MISC_OFF);
    const int tid = threadIdx.x;
    for (int u = tid; u < (LDS_BYTES - MISC_OFF) / 4; u += NTHREADS) ((LAS unsigned*)(lds + MISC_OFF))[u] = 0u;
    __syncthreads();
    unsigned char* ws = p.ws;
    unsigned* barw = (unsigned*)(ws + WS_CTL) + CW_BAR;
    const bool multi = (p.ph_hi - p.ph_lo) > 1;
    XcdBarrier bar; bar.bar = barw; bar.x = 0; bar.st = nullptr;
    if (multi) bar = xcd_barrier_post(barw, MISC + 8);
    const int lo = p.ph_lo, hi = p.ph_hi;
#ifndef PH_MASK
#define PH_MASK 0xFFFFFu
#endif
#define IN(k) ((((PH_MASK) >> (k)) & 1u) && lo <= (k) && (k) < hi)
#define SEAM(k) do { if (IN(k) && IN((k) + 1)) xcd_barrier(bar); } while (0)
    const int G = gridDim.x, bx = blockIdx.x;
    LAS int* OFFS = (LAS int*)(lds + MISC_OFF + 64); LAS int* TOT = OFFS + 64; LAS int* TILE_E = TOT + 64;

    if (IN(0)) { phase_prologue(p, lds); } SEAM(0);
    if (IN(1)) { phase_finalize(p); } SEAM(1);
    if (IN(2)) { phase_norm_mix0(p); } SEAM(2);
    if (IN(3)) {
        pg8::Gemm g{(const bf16_t*)(ws + WS_HB), (const bf16_t*)(ws + WS_WIN0), D, nullptr};
        InProj0Order S; S.so.init(M, 7168, G, bx);
        EpiInProj0 E{ws, (const float*)(ws + WS_LB)};
        pg8::gemm_phase<EpiInProj0, InProj0Order, false>(lds, g, S, E);
    } SEAM(3);
    if (IN(4)) {
        for (int c = bx; c < 256; c += G) { __syncthreads(); phase_scan(p, lds, c); }
    } SEAM(4);
    if (IN(5)) {
        for (int u = bx; u < 256; u += G) phase_gmlp(p, lds, u);
        phase_hgrn_out(p);
    } SEAM(5);
    if (IN(6)) {
        pg8::Gemm g{(const bf16_t*)(ws + WS_HB), (const bf16_t*)(ws + WS_WOUT0), D, nullptr};
        pg8::StaticOrder S; S.init(M, D, G, bx);
        EpiResid<true> E{p.in[0], (bf16_t*)(ws + WS_XB), (const float*)(ws + WS_MOD) + 2 * 2048};
        pg8::gemm_phase<EpiResid<true>, pg8::StaticOrder, false>(lds, g, S, E);
    } SEAM(6);
#define MOE_BLOCK(l, pb) do { \
        if (IN(pb)) { phase_router(p, lds, l); } SEAM(pb); \
        if (IN((pb) + 1)) { phase_dispatch(p, lds); } SEAM((pb) + 1); \
        if (IN((pb) + 2)) { \
            __syncthreads(); moe_tables(p, OFFS, TOT, TILE_E, (LAS int*)lds); \
            pg8::Gemm g{(const bf16_t*)(ws + WS_HB), (const bf16_t*)(ws + WS_EGU) + (size_t)(l) * 32 * 1024 * 2048, D, (const int*)(ws + RT_BUF_TOK)}; \
            MoeOrder S{G, bx, 4, (OFFS[32] / 256) * 4, TILE_E}; \
            EpiGateUp E{(bf16_t*)(ws + WS_HMID)}; \
            pg8::gemm_phase<EpiGateUp, MoeOrder, true>(lds, g, S, E); \
        } SEAM((pb) + 2); \
        if (IN((pb) + 3)) { \
            __syncthreads(); moe_tables(p, OFFS, TOT, TILE_E, (LAS int*)lds); \
            pg8::Gemm g{(const bf16_t*)(ws + WS_HMID), (const bf16_t*)(ws + WS_EDN) + (size_t)(l) * 32 * 2048 * 512, EFF, nullptr}; \
            MoeOrder S{G, bx, 8, (OFFS[32] / 256) * 8, TILE_E}; \
            EpiDown E{(bf16_t*)(ws + WS_Y), (const float*)(ws + RT_BUF_W)}; \
            pg8::gemm_phase<EpiDown, MoeOrder, false>(lds, g, S, E); \
        } SEAM((pb) + 3); \
        if (IN((pb) + 4)) { phase_moe_combine(p, lds, l, (l) == 1); } SEAM((pb) + 4); \
    } while (0)
    MOE_BLOCK(0, 7);
    if (IN(12)) {
        pg8::Gemm g{(const bf16_t*)(ws + WS_HB), (const bf16_t*)(ws + WS_WIN1), D, nullptr};
        pg8::StaticOrder S; S.init(M, 6144, G, bx);
        EpiOddIn E{(bf16_t*)(ws + WS_P1), (bf16_t*)(ws + WS_P1 + P1_STRIDE)};
        pg8::gemm_phase<EpiOddIn, pg8::StaticOrder, false>(lds, g, S, E);
    } SEAM(12);
    if (IN(13)) { phase_conv(p); } SEAM(13);
    if (IN(14)) {
        pg8::Gemm g{(const bf16_t*)(ws + WS_HB), (const bf16_t*)(ws + WS_WOUT1), D, nullptr};
        pg8::StaticOrder S; S.init(M, D, G, bx);
        EpiResid<false> E{ws + WS_XB, (bf16_t*)(ws + WS_XB), (const float*)(ws + WS_MOD) + 9 * 12288 + 2 * 2048};
        pg8::gemm_phase<EpiResid<false>, pg8::StaticOrder, false>(lds, g, S, E);
    } SEAM(14);
    MOE_BLOCK(1, 15);
#undef MOE_BLOCK
#undef IN
#undef SEAM
}

extern "C" void kernel_launch(void* const* d_in, const int* in_sizes, int n_in, void* d_out, int out_size, void* d_ws, size_t ws_size, hipStream_t stream) {
    static int grid = 0;
    if (grid == 0) {
        if (n_in != 27 || out_size != M * D || ws_size < WS_END) { fprintf(stderr, "kernel_launch: unexpected shapes: n_in %d out %d ws %zu (need %zu)\n", n_in, out_size, ws_size, (size_t)WS_END); grid = -1; return; }
        int dev = 0, cus = 0, per_cu = 0;
        if (hipGetDevice(&dev) != hipSuccess || hipDeviceGetAttribute(&cus, hipDeviceAttributeMultiprocessorCount, dev) != hipSuccess) { grid = -1; return; }
        if (hipFuncSetAttribute((const void*)fwd_kernel, hipFuncAttributeMaxDynamicSharedMemorySize, LDS_BYTES) != hipSuccess) { fprintf(stderr, "kernel_launch: hipFuncSetAttribute failed\n"); grid = -1; return; }
        if (hipOccupancyMaxActiveBlocksPerMultiprocessor(&per_cu, (const void*)fwd_kernel, NTHREADS, LDS_BYTES) != hipSuccess || per_cu < 1)
            fprintf(stderr, "kernel_launch: occupancy query reports %d workgroups per CU\n", per_cu);
        (void)hipGetLastError();
        grid = cus;
    }
    if (grid < 0) return;
    (void)hipMemsetAsync((char*)d_ws + WS_CTL, 0, CTL_ZERO_BYTES, stream);
    Params p{};
    for (int i = 0; i < 27; ++i) p.in[i] = (const float*)d_in[i];
    p.out = (float*)d_out; p.ws = (unsigned char*)d_ws;
#if MK_ONE_LAUNCH
    p.ph_lo = 0; p.ph_hi = NPHASES;
    hipLaunchKernelGGL(fwd_kernel, dim3(grid), dim3(NTHREADS), LDS_BYTES, stream, p);
#else
#ifndef MAX_PHASE
#define MAX_PHASE NPHASES
#endif
    for (int ph = 0; ph < MAX_PHASE; ++ph) { p.ph_lo = ph; p.ph_hi = ph + 1; hipLaunchKernelGGL(fwd_kernel, dim3(grid), dim3(NTHREADS), LDS_BYTES, stream, p); }
#endif
}
```

```cpp
#include <hip/hip_runtime.h>
#include <cstdio>
#include <cstdint>

#define LAS __attribute__((address_space(3)))
#define GAS __attribute__((address_space(1)))
typedef unsigned short bf16_t;
typedef short bf16x8 __attribute__((ext_vector_type(8)));
typedef float f32x4 __attribute__((ext_vector_type(4)));
typedef float f32x2 __attribute__((ext_vector_type(2)));
typedef unsigned u32x4 __attribute__((ext_vector_type(4)));
typedef unsigned u32x2 __attribute__((ext_vector_type(2)));

#ifndef MK_ONE_LAUNCH
#define MK_ONE_LAUNCH 1
#endif

constexpr int D = 2048, NB = 8, SEQ = 4096, M = NB * SEQ, CL = 256, MC = NB * CL;
constexpr int WA = 1024, NE = 32, EFF = 512;
constexpr int NASG = 2 * M, MAXROWS = NASG + NE * 256, MAXTILES = MAXROWS / 256;
constexpr float EPS = 1e-6f;
constexpr int NWAVES = 8, NTHREADS = 512;

constexpr size_t MiB = 1u << 20;
constexpr size_t WS_CTL = 0, CTL_ZERO_BYTES = 1 * MiB;
constexpr size_t WS_MOD = 1 * MiB;
constexpr size_t WS_LB = 2 * MiB;
constexpr size_t WS_RW = 3 * MiB;
constexpr size_t WS_RB = 4 * MiB;
constexpr size_t WS_MP = 8 * MiB;
constexpr size_t WS_WIN0 = 22 * MiB, WS_WOUT0 = 50 * MiB, WS_WIN1 = 58 * MiB, WS_WOUT1 = 82 * MiB, WS_EGU = 90 * MiB, WS_EDN = 346 * MiB;
constexpr size_t WS_HB = 474 * MiB;
constexpr size_t WS_R = 610 * MiB;
constexpr size_t WS_Q = WS_R, PROJ_STRIDE = 64 * MiB;
constexpr size_t WS_CTXP = WS_R + 7 * 64 * MiB, CTXP_STRIDE = 4 * MiB;
constexpr size_t WS_OF = WS_CTXP + 12 * MiB, WS_OB = WS_OF + 64 * MiB;
constexpr size_t WS_Y = WS_R, WS_HMID = WS_R + 288 * MiB;
constexpr size_t WS_P1 = WS_R, P1_STRIDE = 128 * MiB;
constexpr size_t WS_RT = 1198 * MiB;
constexpr size_t RT_ASG_E = WS_RT, RT_ASG_R = RT_ASG_E + 262144, RT_ASG_W = RT_ASG_R + 262144, RT_POS = RT_ASG_W + 262144,
                 RT_BUF_TOK = RT_POS + 262144, RT_BUF_W = RT_BUF_TOK + 294912, RT_CNT = RT_BUF_W + 294912;
constexpr size_t WS_XB = 1201 * MiB;
constexpr size_t WS_END = 1329 * MiB;
static_assert(WS_OB + 64 * MiB <= WS_RT && RT_CNT + 32768 <= WS_XB && WS_HMID + 72 * MiB <= WS_RT && WS_P1 + 3 * P1_STRIDE <= WS_RT, "ws map");
constexpr int CW_BAR = 4096;

constexpr int RING_BYTES = 131072;
constexpr int MISC_OFF = 147456;
constexpr int LDS_BYTES = 163840;

typedef __bf16 bf16x2_t __attribute__((ext_vector_type(2)));
__device__ __forceinline__ unsigned cvt_pk_bf16(float lo, float hi) { const f32x2 v = {lo, hi}; return __builtin_bit_cast(unsigned, __builtin_convertvector(v, bf16x2_t)); }
__device__ __forceinline__ float bf_lo(unsigned w) { return __uint_as_float(w << 16); }
__device__ __forceinline__ float bf_hi(unsigned w) { return __uint_as_float(w & 0xffff0000u); }
__device__ __forceinline__ float bf2f(bf16_t b) { return __uint_as_float(((unsigned)b) << 16); }
__device__ __forceinline__ float wave_sum(float v) {
#pragma unroll
    for (int o = 1; o < 64; o <<= 1) v += __shfl_xor(v, o);
    return v;
}
__device__ __forceinline__ float fast_sigmoid(float x) { return __builtin_amdgcn_rcpf(1.0f + __expf(-x)); }
__device__ __forceinline__ float silu_f(float x) { return x * fast_sigmoid(x); }
__device__ __forceinline__ float gelu_tanh_f(float x) { const float u = 0.7978845608028654f * (x + 0.044715f * x * x * x); return x * fast_sigmoid(2.0f * u); }
#define LDS_WAIT() asm volatile("s_waitcnt lgkmcnt(0)" ::: "memory")
#define VM_WAIT() asm volatile("s_waitcnt vmcnt(0)" ::: "memory")
#define LDS_BARRIER() do { asm volatile("s_waitcnt lgkmcnt(0)" ::: "memory"); __builtin_amdgcn_s_barrier(); asm volatile("" ::: "memory"); } while (0)

#define XB_TMO      128
#define XB_XCNT(j)  (256  + 64 * (j))
#define XB_XSUB(j)  (1280 + 64 * (j))
#define XB_XGEN(j)  (2304 + 64 * (j))
#define XB_TOP      3328
#define XB_TOPGEN   3392
#define XCD_BAR_WORDS 3456
#define XB_SPIN_CAP (1u << 22)
__device__ __forceinline__ unsigned xb_ld(unsigned* p)              { return __hip_atomic_load(p, __ATOMIC_RELAXED, __HIP_MEMORY_SCOPE_AGENT); }
__device__ __forceinline__ unsigned xb_add(unsigned* p, unsigned v) { return __hip_atomic_fetch_add(p, v, __ATOMIC_RELAXED, __HIP_MEMORY_SCOPE_AGENT); }
__device__ __forceinline__ unsigned xb_xcc_id() { return (unsigned)__builtin_amdgcn_s_getreg((3 << 11) | 20) & 0xFu; }
#define XB_SPIN(cond, bar) do { unsigned _sp = 0; while (cond) { __builtin_amdgcn_s_sleep(1); \
    if ((++_sp & 255u) == 0u) { if (xb_ld(&(bar)[XB_TMO])) break; if (_sp > XB_SPIN_CAP) { atomicAdd(&(bar)[XB_TMO], 1u); break; } } } } while (0)
struct XcdBarrier { unsigned* bar; unsigned x; volatile LAS unsigned* st; };
__device__ __forceinline__ XcdBarrier xcd_barrier_post(unsigned* bar, volatile LAS unsigned* st) {
    XcdBarrier b; b.bar = bar; b.x = xb_xcc_id(); b.st = st;
    if (threadIdx.x == 0) (void)xb_add(&bar[XB_XCNT(b.x)], 1u);
    return b;
}
__device__ __forceinline__ void xcd_barrier_complete(unsigned* bar, unsigned x, unsigned& nloc, unsigned& nx) {
    const unsigned G = gridDim.x * gridDim.y * gridDim.z;
    unsigned sum, cnt, mine, sp = 0u;
    for (;;) {
        sum = 0u; cnt = 0u; mine = 0u;
#pragma unroll
        for (unsigned j = 0; j < 16; ++j) { const unsigned c = xb_ld(&bar[XB_XCNT(j)]); sum += c; cnt += (c > 0u) ? 1u : 0u; mine = (j == x) ? c : mine; }
        if (sum == G) break;
        __builtin_amdgcn_s_sleep(1);
        if ((++sp & 255u) == 0u) { if (xb_ld(&bar[XB_TMO])) break; if (sp > XB_SPIN_CAP) { atomicAdd(&bar[XB_TMO], 1u); break; } }
    }
    nloc = mine > 0u ? mine : 1u; nx = cnt > 0u ? cnt : 1u;
}
__device__ __forceinline__ void xcd_barrier(const XcdBarrier& b) {
    asm volatile("s_waitcnt vmcnt(0)" ::: "memory");
    __syncthreads();
    if (threadIdx.x == 0) {
        unsigned* bar = b.bar;
        __builtin_amdgcn_s_waitcnt(0);
        unsigned nloc = b.st[0], nx = b.st[1];
        if (nloc == 0u) { xcd_barrier_complete(bar, b.x, nloc, nx); b.st[0] = nloc; b.st[1] = nx; }
        const unsigned old = xb_add(&bar[XB_XSUB(b.x)], 1u);
        const unsigned gen = old / nloc;
        if (old + 1u == (gen + 1u) * nloc) {
            __builtin_amdgcn_fence(__ATOMIC_RELEASE, "agent");
            asm volatile("s_waitcnt vmcnt(0)" ::: "memory");
            const unsigned og = xb_add(&bar[XB_TOP], 1u);
            const unsigned tg = og / nx;
            if (og + 1u == (tg + 1u) * nx) xb_add(&bar[XB_TOPGEN], 1u);
            else XB_SPIN(xb_ld(&bar[XB_TOPGEN]) == tg, bar);
            __builtin_amdgcn_fence(__ATOMIC_ACQUIRE, "agent");
            xb_add(&bar[XB_XGEN(b.x)], 1u);
            asm volatile("s_waitcnt vmcnt(0)" ::: "memory");
        } else {
            XB_SPIN(xb_ld(&bar[XB_XGEN(b.x)]) == gen, bar);
            __builtin_amdgcn_fence(__ATOMIC_ACQUIRE, "agent");
            asm volatile("s_waitcnt vmcnt(0)" ::: "memory");
        }
    }
    __syncthreads();
}

namespace pg8 {
constexpr int BM = 256, BK = 64, HALF = 128, HTB = HALF * BK * 2, STAGE_BYTES = 8 * HTB, NXCD = 8, WGM = 8;
__host__ __device__ __forceinline__ int lds_byte(int r, int c) { const int st = (r >> 4) * 2 + (c >> 5), rr = r & 15, cc = c & 31, ob = rr * 64 + cc * 2; return st * 1024 + (ob ^ (((ob >> 9) & 1) << 5)); }
__host__ __device__ __forceinline__ void stage_rc(int b, int& R, int& C) { const int st = b / 1024, sb = b % 1024, swz = sb ^ (((sb >> 9) & 1) << 5); R = (st >> 1) * 16 + swz / 64; C = (st & 1) * 32 + (swz % 64) / 2; }
__host__ __device__ __forceinline__ int perm32(int rho) { const int n = rho >> 4, i = rho & 15; return 8 * (i >> 2) + 4 * n + (i & 3); }
struct Unit { int pm, pn, pb; };
struct Gemm { const bf16_t* A; const bf16_t* Bt; int K; const int* rowtab; };
struct StaticOrder {
    int nM, nN, nwg, G, c;
    __device__ void init(int Mr, int N, int G_, int c_) { nM = Mr / BM; nN = N / BM; nwg = nM * nN; G = G_; c = c_; }
    __device__ __forceinline__ bool map(long Lu, Unit& u) const {
        if (Lu >= nwg) return false;
        int wgid = (int)Lu; { const int q = nwg / NXCD, r = nwg % NXCD, xcd = wgid % NXCD, off = wgid / NXCD; wgid = (xcd < r ? xcd * (q + 1) : r * (q + 1) + (xcd - r) * q) + off; }
        const int nig = WGM * nN, gid = wgid / nig, fm = gid * WGM, gsz = (nM - fm) < WGM ? (nM - fm) : WGM;
        u.pm = fm + ((wgid % nig) % gsz); u.pn = (wgid % nig) / gsz; u.pb = u.pn; return true;
    }
    __device__ __forceinline__ bool next(int i, Unit& u) const { return map((long)i * G + c, u); }
};

template <class Epi, class Sched, bool GATHER>
__device__ __forceinline__ void gemm_phase(LAS unsigned char* lds, const Gemm g, const Sched& S, const Epi& E) {
    const int tid = threadIdx.x, wid = __builtin_amdgcn_readfirstlane(tid >> 6), lane = tid & 63, wr = wid >> 2, wc = wid & 3, fr = lane & 15, fq = lane >> 4;
    const int K = g.K, nt = K / BK;
    unsigned voffB[2]; int rA[2]; unsigned cA2[2];
#pragma unroll
    for (int i = 0; i < 2; ++i) { int R, C; stage_rc(tid * 16 + i * 8192, R, C); const int Rb = Epi::COLMAP64 ? (64 * (R >> 5) + perm32(R & 31)) : (Epi::PERM ? ((R & ~31) + perm32(R & 31)) : R);
        rA[i] = R; cA2[i] = (unsigned)C * 2u; voffB[i] = (unsigned)(Rb * K + C) * 2u; }
    const size_t kstep = (size_t)(BK * 2);
    const size_t hstep = (size_t)(Epi::COLMAP64 ? 32 : HALF) * K * 2;
    const size_t tstep = (size_t)BM * K * 2;
    const unsigned ldsw = (unsigned)wid * 1024u;
    const int aoff = lds_byte(wr * 64 + fr, fq * 8), boff = lds_byte(wc * 32 + fr, fq * 8);
    const unsigned rowbytes = (unsigned)K * 2u;
#define PG8_SA(b, h) (((b) * 2 + (h)) * HTB)
#define PG8_SB(b, h) ((4 + (b) * 2 + (h)) * HTB)
#define PG8_STAGE(bufoff, gbase, voff) do { _Pragma("unroll") for (int _i = 0; _i < 2; ++_i) \
        __builtin_amdgcn_global_load_lds((const unsigned*)((const char*)(gbase) + (voff)[_i]), (LAS unsigned*)(lds + (bufoff) + ldsw + _i * 8192), 16, 0, 0); } while (0)
#define PG8_STAGE2(bufoff, gbase, o0, o1) do { \
        __builtin_amdgcn_global_load_lds((const unsigned*)((const char*)(gbase) + (o0)), (LAS unsigned*)(lds + (bufoff) + ldsw), 16, 0, 0); \
        __builtin_amdgcn_global_load_lds((const unsigned*)((const char*)(gbase) + (o1)), (LAS unsigned*)(lds + (bufoff) + ldsw + 8192), 16, 0, 0); } while (0)
#define PG8_LDA(dst, b, h) do { _Pragma("unroll") for (int m = 0; m < 4; ++m) _Pragma("unroll") for (int k = 0; k < 2; ++k) dst[m][k] = *(const LAS bf16x8*)(lds + PG8_SA(b, h) + aoff + m * 2048 + k * 1024); } while (0)
#define PG8_LDB(dst, b, h) do { _Pragma("unroll") for (int n = 0; n < 2; ++n) _Pragma("unroll") for (int k = 0; k < 2; ++k) dst[n][k] = *(const LAS bf16x8*)(lds + PG8_SB(b, h) + boff + n * 2048 + k * 1024); } while (0)
#define PG8_MMA(ai, bj, At, Bt) do { __builtin_amdgcn_s_setprio(1); _Pragma("unroll") for (int m = 0; m < 4; ++m) _Pragma("unroll") for (int n = 0; n < 2; ++n) _Pragma("unroll") for (int k = 0; k < 2; ++k) \
        acc[ai][bj][m][n] = __builtin_amdgcn_mfma_f32_16x16x32_bf16(Bt[n][k], At[m][k], acc[ai][bj][m][n], 0, 0, 0); __builtin_amdgcn_s_setprio(0); } while (0)
#define PG8_WAIT_V(n) asm volatile("s_waitcnt vmcnt(" #n ")" ::: "memory")
#define PG8_WAIT_L(n) asm volatile("s_waitcnt lgkmcnt(" #n ")" ::: "memory")
#define PG8_BAR __builtin_amdgcn_s_barrier()
#define PG8_SCHED __builtin_amdgcn_sched_barrier(0)
#define PG8_AOFF(dst, u) do { _Pragma("unroll") for (int _h = 0; _h < 2; ++_h) _Pragma("unroll") for (int _i = 0; _i < 2; ++_i) { \
        const int _r = (u).pm * BM + _h * HALF + rA[_i]; const unsigned _row = GATHER ? (unsigned)g.rowtab[_r] : (unsigned)_r; dst[_h][_i] = _row * rowbytes + cA2[_i]; } } while (0)
    Unit cur, nxt; int ui = 0;
    if (!S.next(0, cur)) return;
    f32x4 acc[2][2][4][2];
#pragma unroll
    for (int a = 0; a < 2; ++a)
#pragma unroll
        for (int b = 0; b < 2; ++b)
#pragma unroll
            for (int m = 0; m < 4; ++m)
#pragma unroll
                for (int n = 0; n < 2; ++n) acc[a][b][m][n] = (f32x4){0.f, 0.f, 0.f, 0.f};
    bf16x8 At[4][2], B0[2][2], B1[2][2];
    unsigned ga[2][2], gn[2][2];
    PG8_AOFF(ga, cur);
    const char* const A0 = (const char*)g.A;
    const char* cB = (const char*)g.Bt + (size_t)cur.pb * tstep;
    PG8_STAGE(PG8_SB(0, 0), cB, voffB); PG8_STAGE2(PG8_SA(0, 0), A0, ga[0][0], ga[0][1]); PG8_STAGE(PG8_SB(0, 1), cB + hstep, voffB); PG8_STAGE2(PG8_SA(0, 1), A0, ga[1][0], ga[1][1]);
    if (wr == 1) PG8_BAR;
    PG8_WAIT_V(4); PG8_BAR;
    PG8_STAGE(PG8_SB(1, 0), cB + kstep, voffB); PG8_STAGE2(PG8_SA(1, 0), A0 + kstep, ga[0][0], ga[0][1]); PG8_STAGE(PG8_SB(1, 1), cB + hstep + kstep, voffB);
    PG8_WAIT_V(6); PG8_BAR;
    for (;;) {
        const bool has_next = S.next(ui + 1, nxt);
        if (has_next) { PG8_AOFF(gn, nxt); } else {
#pragma unroll
            for (int h = 0; h < 2; ++h)
#pragma unroll
                for (int i = 0; i < 2; ++i) gn[h][i] = ga[h][i]; }
        const char* nB = has_next ? (const char*)g.Bt + (size_t)nxt.pb * tstep : cB;
        for (int t = 0; t < nt; t += 2) {
            const bool last = (t == nt - 2);
            const char* a1 = A0 + (size_t)(t + 1) * kstep;
            const char* a2 = last ? A0 : A0 + (size_t)(t + 2) * kstep; const char* b2 = last ? nB : cB + (size_t)(t + 2) * kstep;
            const char* a3 = a2 + kstep; const char* b3 = b2 + kstep;
            const unsigned o00 = last ? gn[0][0] : ga[0][0], o01 = last ? gn[0][1] : ga[0][1], o10 = last ? gn[1][0] : ga[1][0], o11 = last ? gn[1][1] : ga[1][1];
            PG8_LDB(B0, 0, 0); PG8_SCHED; PG8_LDA(At, 0, 0); PG8_STAGE2(PG8_SA(1, 1), a1, ga[1][0], ga[1][1]);
            PG8_WAIT_L(8); PG8_BAR; PG8_WAIT_L(0); PG8_MMA(0, 0, At, B0); PG8_BAR; PG8_SCHED;
            PG8_LDB(B1, 0, 1); PG8_STAGE(PG8_SB(0, 0), b2, voffB);
            PG8_BAR; PG8_WAIT_L(0); PG8_MMA(0, 1, At, B1); PG8_BAR;
            PG8_LDA(At, 0, 1); PG8_STAGE2(PG8_SA(0, 0), a2, o00, o01);
            PG8_BAR; PG8_WAIT_L(0); PG8_MMA(1, 0, At, B0); PG8_BAR; PG8_SCHED;
            PG8_STAGE(PG8_SB(0, 1), b2 + hstep, voffB);
            PG8_WAIT_V(6); PG8_BAR; PG8_MMA(1, 1, At, B1); PG8_BAR;
            PG8_LDB(B0, 1, 0); PG8_SCHED; PG8_LDA(At, 1, 0); PG8_STAGE2(PG8_SA(0, 1), a2, o10, o11);
            PG8_WAIT_L(8); PG8_BAR; PG8_WAIT_L(0); PG8_MMA(0, 0, At, B0); PG8_BAR; PG8_SCHED;
            PG8_LDB(B1, 1, 1); PG8_STAGE(PG8_SB(1, 0), b3, voffB);
            PG8_BAR; PG8_WAIT_L(0); PG8_MMA(0, 1, At, B1); PG8_BAR;
            PG8_LDA(At, 1, 1); PG8_STAGE2(PG8_SA(1, 0), a3, o00, o01);
            PG8_BAR; PG8_WAIT_L(0); PG8_MMA(1, 0, At, B0); PG8_BAR; PG8_SCHED;
            PG8_STAGE(PG8_SB(1, 1), b3 + hstep, voffB);
            PG8_WAIT_V(6); PG8_BAR; PG8_MMA(1, 1, At, B1); PG8_BAR;
        }
        E(acc, cur, wr, wc, fr, fq);
        if (!has_next) break;
#pragma unroll
        for (int a = 0; a < 2; ++a)
#pragma unroll
            for (int b = 0; b < 2; ++b)
#pragma unroll
                for (int m = 0; m < 4; ++m)
#pragma unroll
                    for (int n = 0; n < 2; ++n) acc[a][b][m][n] = (f32x4){0.f, 0.f, 0.f, 0.f};
        cur = nxt; cB = nB; ++ui;
#pragma unroll
        for (int h = 0; h < 2; ++h)
#pragma unroll
            for (int i = 0; i < 2; ++i) ga[h][i] = gn[h][i];
    }
    PG8_WAIT_V(0);
    if (wr == 0) PG8_BAR;
    PG8_BAR;
#undef PG8_SA
#undef PG8_SB
#undef PG8_STAGE
#undef PG8_STAGE2
#undef PG8_LDA
#undef PG8_LDB
#undef PG8_MMA
#undef PG8_WAIT_V
#undef PG8_WAIT_L
#undef PG8_BAR
#undef PG8_SCHED
#undef PG8_AOFF
}
}

struct Params {
    const float* in[27];
    float* out;
    unsigned char* ws;
    int ph_lo, ph_hi;
};

struct EpiInProj0 {
    static constexpr bool PERM = true, COLMAP64 = false;
    unsigned char* ws; const float* lb;
    __device__ __forceinline__ void operator()(const f32x4 (&acc)[2][2][4][2], const pg8::Unit& u, int wr, int wc, int fr, int fq) const {
        const int t = u.pn >> 2;
        const bool ctx = u.pm >= M / 256;
        bf16_t* base = ctx ? (bf16_t*)(ws + WS_CTXP + (size_t)(t - 1) * CTXP_STRIDE) : (bf16_t*)(ws + WS_Q + (size_t)t * PROJ_STRIDE);
        const int row0 = (ctx ? u.pm * 256 - M : u.pm * 256) + wr * 64 + fr;
        const int col0 = (u.pn & 3) * 256 + wc * 32 + 8 * fq;
        const bool headmajor = t < 4;
        const int Ls = ctx ? CL : SEQ;
        f32x4 lbv[2][2];
        if (t == 1 || t == 2) {
#pragma unroll
            for (int bj = 0; bj < 2; ++bj)
#pragma unroll
                for (int n = 0; n < 2; ++n) lbv[bj][n] = *(const f32x4*)(lb + (t - 1) * 1024 + col0 + bj * 128 + 4 * n);
        }
#pragma unroll
        for (int ai = 0; ai < 2; ++ai)
#pragma unroll
            for (int m = 0; m < 4; ++m) { const int rr = row0 + ai * 128 + m * 16; const int bb = rr / Ls, pos = rr - bb * Ls;
#pragma unroll
                for (int bj = 0; bj < 2; ++bj) { f32x4 v0 = acc[ai][bj][m][0], v1 = acc[ai][bj][m][1]; u32x4 w;
                    bf16_t* dstp = headmajor ? base + ((size_t)(bb * 8 + (u.pn & 3) * 2 + bj) * Ls + pos) * 128 + wc * 32 + 8 * fq : base + (size_t)rr * 1024 + col0 + bj * 128;
                    if (t == 1 || t == 2) {
                        _Float16 hv[8];
#pragma unroll
                        for (int j = 0; j < 4; ++j) { const float l0 = lbv[bj][0][j], l1 = lbv[bj][1][j];
                            const float f0 = l0 + (1.0f - l0) * fast_sigmoid(v0[j]), f1 = l1 + (1.0f - l1) * fast_sigmoid(v1[j]);
                            hv[j] = (_Float16)f0; hv[4 + j] = (_Float16)f1; }
                        w.x = (unsigned)__builtin_bit_cast(unsigned short, hv[0]) | ((unsigned)__builtin_bit_cast(unsigned short, hv[1]) << 16);
                        w.y = (unsigned)__builtin_bit_cast(unsigned short, hv[2]) | ((unsigned)__builtin_bit_cast(unsigned short, hv[3]) << 16);
                        w.z = (unsigned)__builtin_bit_cast(unsigned short, hv[4]) | ((unsigned)__builtin_bit_cast(unsigned short, hv[5]) << 16);
                        w.w = (unsigned)__builtin_bit_cast(unsigned short, hv[6]) | ((unsigned)__builtin_bit_cast(unsigned short, hv[7]) << 16);
                    } else {
                        if (t == 0 || t == 4) {
#pragma unroll
                            for (int j = 0; j < 4; ++j) { v0[j] = silu_f(v0[j]); v1[j] = silu_f(v1[j]); }
                        } else if (t >= 5) {
#pragma unroll
                            for (int j = 0; j < 4; ++j) { v0[j] = gelu_tanh_f(v0[j]); v1[j] = gelu_tanh_f(v1[j]); }
                        }
                        w.x = cvt_pk_bf16(v0[0], v0[1]); w.y = cvt_pk_bf16(v0[2], v0[3]); w.z = cvt_pk_bf16(v1[0], v1[1]); w.w = cvt_pk_bf16(v1[2], v1[3]);
                    }
                    *(u32x4*)dstp = w; } }
    }
};
struct InProj0Order {
    pg8::StaticOrder so;
    __device__ __forceinline__ bool next(int i, pg8::Unit& u) const {
        const long Lu = (long)i * so.G + so.c;
        if (Lu < so.nwg) return so.map(Lu, u);
        const int r = (int)(Lu - so.nwg); if (r >= 96) return false;
        u.pm = M / 256 + r / 12; u.pn = 4 + r % 12; u.pb = u.pn; return true;
    }
};
struct EpiOddIn {
    static constexpr bool PERM = true, COLMAP64 = false;
    bf16_t* Z; bf16_t* BG;
    __device__ __forceinline__ void operator()(const f32x4 (&acc)[2][2][4][2], const pg8::Unit& u, int wr, int wc, int fr, int fq) const {
        const int row0 = u.pm * 256 + wr * 64 + fr;
        if (u.pn < 16) {
            const int col0 = u.pn * 128 + wc * 32 + 8 * fq;
#pragma unroll
            for (int ai = 0; ai < 2; ++ai)
#pragma unroll
                for (int m = 0; m < 4; ++m) { const f32x4 v0 = acc[ai][0][m][0] * acc[ai][1][m][0], v1 = acc[ai][0][m][1] * acc[ai][1][m][1]; u32x4 w;
                    w.x = cvt_pk_bf16(v0[0], v0[1]); w.y = cvt_pk_bf16(v0[2], v0[3]); w.z = cvt_pk_bf16(v1[0], v1[1]); w.w = cvt_pk_bf16(v1[2], v1[3]);
                    *(u32x4*)(Z + (size_t)(row0 + ai * 128 + m * 16) * 2048 + col0) = w; }
        } else {
            const int col0 = (u.pn - 16) * 256 + wc * 32 + 8 * fq;
#pragma unroll
            for (int ai = 0; ai < 2; ++ai)
#pragma unroll
                for (int m = 0; m < 4; ++m) { bf16_t* rowp = BG + (size_t)(row0 + ai * 128 + m * 16) * 2048 + col0;
#pragma unroll
                    for (int bj = 0; bj < 2; ++bj) { const f32x4 v0 = acc[ai][bj][m][0], v1 = acc[ai][bj][m][1]; u32x4 w;
                        w.x = cvt_pk_bf16(v0[0], v0[1]); w.y = cvt_pk_bf16(v0[2], v0[3]); w.z = cvt_pk_bf16(v1[0], v1[1]); w.w = cvt_pk_bf16(v1[2], v1[3]);
                        *(u32x4*)(rowp + bj * 128) = w; } }
        }
    }
};
template <bool IN_F32> struct EpiResid {
    static constexpr bool PERM = true, COLMAP64 = false;
    const void* xin; bf16_t* xout; const float* gate;
    __device__ __forceinline__ void operator()(const f32x4 (&acc)[2][2][4][2], const pg8::Unit& u, int wr, int wc, int fr, int fq) const {
        const int row0 = u.pm * 256 + wr * 64 + fr, col0 = u.pn * 256 + wc * 32 + 8 * fq;
        const int b = (u.pm * 256) / SEQ;
        unsigned yp[2][4][2][4];
#pragma unroll
        for (int bj = 0; bj < 2; ++bj)
#pragma unroll
            for (int n = 0; n < 2; ++n) { const f32x4 gv = *(const f32x4*)(gate + (size_t)b * 12288 + col0 + bj * 128 + n * 4);
#pragma unroll
                for (int ai = 0; ai < 2; ++ai)
#pragma unroll
                    for (int m = 0; m < 4; ++m) { const f32x4 y = gv * acc[ai][bj][m][n]; yp[ai][m][bj][2 * n] = cvt_pk_bf16(y.x, y.y); yp[ai][m][bj][2 * n + 1] = cvt_pk_bf16(y.z, y.w); } }
        asm volatile("" ::: "memory");
        if (IN_F32) {
#pragma unroll
            for (int ai = 0; ai < 2; ++ai) {
                f32x4 xi[4][2][2];
#pragma unroll
                for (int m = 0; m < 4; ++m) { const float* xp = (const float*)xin + (size_t)(row0 + ai * 128 + m * 16) * D + col0;
#pragma unroll
                    for (int bj = 0; bj < 2; ++bj) { xi[m][bj][0] = *(const f32x4*)(xp + bj * 128); xi[m][bj][1] = *(const f32x4*)(xp + bj * 128 + 4); } }
                asm volatile("" ::: "memory");
#pragma unroll
                for (int m = 0; m < 4; ++m) { bf16_t* op = xout + (size_t)(row0 + ai * 128 + m * 16) * D + col0;
#pragma unroll
                    for (int bj = 0; bj < 2; ++bj) { const unsigned* y = yp[ai][m][bj]; const f32x4 x0 = xi[m][bj][0], x1 = xi[m][bj][1];
                        u32x4 w; w.x = cvt_pk_bf16(x0.x + bf_lo(y[0]), x0.y + bf_hi(y[0])); w.y = cvt_pk_bf16(x0.z + bf_lo(y[1]), x0.w + bf_hi(y[1]));
                        w.z = cvt_pk_bf16(x1.x + bf_lo(y[2]), x1.y + bf_hi(y[2])); w.w = cvt_pk_bf16(x1.z + bf_lo(y[3]), x1.w + bf_hi(y[3]));
                        *(u32x4*)(op + bj * 128) = w; } }
                asm volatile("" ::: "memory");
            }
        } else {
            u32x4 xi[2][4][2];
#pragma unroll
            for (int ai = 0; ai < 2; ++ai)
#pragma unroll
                for (int m = 0; m < 4; ++m) { const bf16_t* xp = (const bf16_t*)xin + (size_t)(row0 + ai * 128 + m * 16) * D + col0;
#pragma unroll
                    for (int bj = 0; bj < 2; ++bj) xi[ai][m][bj] = *(const u32x4*)(xp + bj * 128); }
            asm volatile("" ::: "memory");
#pragma unroll
            for (int ai = 0; ai < 2; ++ai)
#pragma unroll
                for (int m = 0; m < 4; ++m) { bf16_t* op = xout + (size_t)(row0 + ai * 128 + m * 16) * D + col0;
#pragma unroll
                    for (int bj = 0; bj < 2; ++bj) { const unsigned* y = yp[ai][m][bj]; const u32x4 xw = xi[ai][m][bj];
                        u32x4 w; w.x = cvt_pk_bf16(bf_lo(xw.x) + bf_lo(y[0]), bf_hi(xw.x) + bf_hi(y[0])); w.y = cvt_pk_bf16(bf_lo(xw.y) + bf_lo(y[1]), bf_hi(xw.y) + bf_hi(y[1]));
                        w.z = cvt_pk_bf16(bf_lo(xw.z) + bf_lo(y[2]), bf_hi(xw.z) + bf_hi(y[2])); w.w = cvt_pk_bf16(bf_lo(xw.w) + bf_lo(y[3]), bf_hi(xw.w) + bf_hi(y[3]));
                        *(u32x4*)(op + bj * 128) = w; } }
        }
    }
};
struct EpiGateUp {
    static constexpr bool PERM = true, COLMAP64 = false;
    bf16_t* H;
    __device__ __forceinline__ void operator()(const f32x4 (&acc)[2][2][4][2], const pg8::Unit& u, int wr, int wc, int fr, int fq) const {
        const int row0 = u.pm * 256 + wr * 64 + fr, col0 = u.pn * 128 + wc * 32 + 8 * fq;
#pragma unroll
        for (int ai = 0; ai < 2; ++ai)
#pragma unroll
            for (int m = 0; m < 4; ++m) { bf16_t* rowp = H + (size_t)(row0 + ai * 128 + m * 16) * EFF + col0;
                f32x4 v0, v1;
#pragma unroll
                for (int j = 0; j < 4; ++j) { v0[j] = silu_f(acc[ai][0][m][0][j]) * acc[ai][1][m][0][j]; v1[j] = silu_f(acc[ai][0][m][1][j]) * acc[ai][1][m][1][j]; }
                u32x4 w; w.x = cvt_pk_bf16(v0[0], v0[1]); w.y = cvt_pk_bf16(v0[2], v0[3]); w.z = cvt_pk_bf16(v1[0], v1[1]); w.w = cvt_pk_bf16(v1[2], v1[3]);
                *(u32x4*)rowp = w; }
    }
};
struct EpiDown {
    static constexpr bool PERM = true, COLMAP64 = false;
    bf16_t* Y; const float* bw;
    __device__ __forceinline__ void operator()(const f32x4 (&acc)[2][2][4][2], const pg8::Unit& u, int wr, int wc, int fr, int fq) const {
        const int row0 = u.pm * 256 + wr * 64 + fr, col0 = u.pn * 256 + wc * 32 + 8 * fq;
        float sc[2][4];
#pragma unroll
        for (int ai = 0; ai < 2; ++ai)
#pragma unroll
            for (int m = 0; m < 4; ++m) sc[ai][m] = bw[row0 + ai * 128 + m * 16];
        asm volatile("" ::: "memory");
#pragma unroll
        for (int ai = 0; ai < 2; ++ai)
#pragma unroll
            for (int m = 0; m < 4; ++m) { const int row = row0 + ai * 128 + m * 16; bf16_t* rowp = Y + (size_t)row * D + col0;
#pragma unroll
                for (int bj = 0; bj < 2; ++bj) { const f32x4 v0 = acc[ai][bj][m][0] * sc[ai][m], v1 = acc[ai][bj][m][1] * sc[ai][m]; u32x4 w;
                    w.x = cvt_pk_bf16(v0[0], v0[1]); w.y = cvt_pk_bf16(v0[2], v0[3]); w.z = cvt_pk_bf16(v1[0], v1[1]); w.w = cvt_pk_bf16(v1[2], v1[3]);
                    *(u32x4*)(rowp + bj * 128) = w; } }
    }
};
struct MoeOrder {
    int G, c, ntn, nunits; const LAS int* tile_e;
    __device__ __forceinline__ bool next(int i, pg8::Unit& u) const {
        int tile, pn;
        if (G == 256) { const int x = c & 7, slot = c >> 3, tpb = 32 / ntn; tile = (i * 8 + x) * tpb + slot % tpb; pn = slot / tpb; if (tile * ntn >= nunits) return false; }
        else { const int Lu = i * G + c; if (Lu >= nunits) return false; tile = Lu / ntn; pn = Lu - tile * ntn; }
        u.pm = tile; u.pn = pn; u.pb = tile_e[tile] * ntn + pn; return true;
    }
};

struct TrItem { const float* src; bf16_t* dst; int ldn, ldk; };
#define TRANSPOSE_LOAD(it, tv) do { _Pragma("unroll") for (int _i = 0; _i < 32; ++_i) tv[_i] = __builtin_nontemporal_load((it).src + (size_t)(2 * _i + (lane >> 5)) * (it).ldn + (lane & 31)); } while (0)
#define TRANSPOSE_STORE(it, tv) do { \
    _Pragma("unroll") for (int _i = 0; _i < 32; ++_i) scr[(2 * _i + (lane >> 5)) * 33 + (lane & 31)] = tv[_i]; \
    LDS_WAIT(); asm volatile("" ::: "memory"); \
    { const int _c = lane & 7; \
      _Pragma("unroll") for (int _j = 0; _j < 4; ++_j) { const int _n = (lane >> 3) + 8 * _j; const LAS float* _sp = scr + (8 * _c) * 33 + _n; \
        u32x4 _o; _o.x = cvt_pk_bf16(_sp[0 * 33], _sp[1 * 33]); _o.y = cvt_pk_bf16(_sp[2 * 33], _sp[3 * 33]); _o.z = cvt_pk_bf16(_sp[4 * 33], _sp[5 * 33]); _o.w = cvt_pk_bf16(_sp[6 * 33], _sp[7 * 33]); \
        *(u32x4*)((it).dst + (size_t)_n * (it).ldk + 8 * _c) = _o; } } \
    LDS_WAIT(); asm volatile("" ::: "memory"); } while (0)
__device__ __forceinline__ TrItem prologue_item(const Params& p, int r) {
    unsigned char* ws = p.ws; TrItem it;
    constexpr int I_IN0 = 32 * 224, I_OUT = 32 * 64, I_IN1 = 32 * 192, I_EXP = 512, NDENSE = I_IN0 + I_OUT + I_IN1 + I_OUT;
    if (r < NDENSE) {
        if (r >= I_IN0 + I_OUT && r < I_IN0 + I_OUT + I_IN1) {
            r -= I_IN0 + I_OUT;
            const int nblk = 192, kb = r / nblk, nb = r % nblk, n0 = 32 * nb;
            const int row = n0 < 2048 ? 256 * (n0 >> 7) + (n0 & 127) : (n0 < 4096 ? 4096 + (n0 - 2048) : 256 * ((n0 - 4096) >> 7) + 128 + ((n0 - 4096) & 127));
            it.src = p.in[17] + (size_t)(64 * kb) * 6144 + n0; it.ldn = 6144; it.dst = (bf16_t*)(ws + WS_WIN1) + (size_t)row * 2048 + 64 * kb; it.ldk = 2048; return it;
        }
        const float* W; bf16_t* WT; int N;
        if (r < I_IN0) { W = p.in[9]; WT = (bf16_t*)(ws + WS_WIN0); N = 7168; }
        else if ((r -= I_IN0) < I_OUT) { W = p.in[10]; WT = (bf16_t*)(ws + WS_WOUT0); N = 2048; }
        else { r -= I_OUT + I_IN1; W = p.in[19]; WT = (bf16_t*)(ws + WS_WOUT1); N = 2048; }
        const int nblk = N / 32, kb = r / nblk, nb = r % nblk;
        it.src = W + (size_t)(64 * kb) * N + 32 * nb; it.ldn = N; it.dst = WT + (size_t)(32 * nb) * 2048 + 64 * kb; it.ldk = 2048; return it;
    }
    r -= NDENSE;
    const int le = r / (3 * I_EXP), rr = r % (3 * I_EXP), which = rr / I_EXP, item = rr % I_EXP;
    if (which < 2) {
        const int kb = item / 16, nb = item % 16, n0 = 32 * nb;
        it.src = (which ? p.in[25] : p.in[24]) + (size_t)le * 2048 * 512 + (size_t)(64 * kb) * 512 + n0; it.ldn = 512;
        it.dst = (bf16_t*)(ws + WS_EGU) + (size_t)le * 1024 * 2048 + (size_t)((n0 >> 7) * 256 + which * 128 + (n0 & 127)) * 2048 + 64 * kb; it.ldk = 2048;
    } else {
        const int kb = item / 64, nb = item % 64;
        it.src = p.in[26] + (size_t)le * 512 * 2048 + (size_t)(64 * kb) * 2048 + 32 * nb; it.ldn = 2048;
        it.dst = (bf16_t*)(ws + WS_EDN) + (size_t)le * 2048 * 512 + (size_t)(32 * nb) * 512 + 64 * kb; it.ldk = 512;
    }
    return it;
}
__device__ __forceinline__ void phase_prologue(const Params& p, LAS unsigned char* lds) {
    const int tid = threadIdx.x, lane = tid & 63, wave = __builtin_amdgcn_readfirstlane(tid >> 6);
    const int gw = blockIdx.x * NWAVES + wave, NGW = gridDim.x * NWAVES;
    unsigned char* ws = p.ws;
    LAS float* SL = (LAS float*)lds;
    for (int idx = tid; idx < 9 * 2048; idx += NTHREADS) { const int r = idx >> 11, k = idx & 2047; const float v = r < 8 ? p.in[1][r * 2048 + k] : p.in[3][k]; SL[idx] = silu_f(v); }
    __syncthreads();
    float* MP = (float*)(ws + WS_MP);
    for (int it = gw; it < 1536; it += NGW) {
        const int l = it / 768, rem = it % 768, cb = rem >> 4, ks = rem & 15;
        const int col0 = cb * 256 + lane * 4, k0 = ks * 128;
        const float* W = p.in[4] + (size_t)l * 2048 * 12288 + col0;
        f32x4 acc[9];
#pragma unroll
        for (int r = 0; r < 9; ++r) acc[r] = (f32x4){0.f, 0.f, 0.f, 0.f};
#pragma unroll 2
        for (int k = k0; k < k0 + 128; k += 4) {
            const f32x4 w0 = __builtin_nontemporal_load((const f32x4*)(W + (size_t)(k + 0) * 12288)), w1 = __builtin_nontemporal_load((const f32x4*)(W + (size_t)(k + 1) * 12288)),
                        w2 = __builtin_nontemporal_load((const f32x4*)(W + (size_t)(k + 2) * 12288)), w3 = __builtin_nontemporal_load((const f32x4*)(W + (size_t)(k + 3) * 12288));
#pragma unroll
            for (int r = 0; r < 9; ++r) { const f32x4 a = *(const LAS f32x4*)(SL + r * 2048 + k); acc[r] += a.x * w0 + a.y * w1 + a.z * w2 + a.w * w3; }
        }
#pragma unroll
        for (int r = 0; r < 9; ++r) *(f32x4*)(MP + ((size_t)((ks * 2 + l) * 9 + r)) * 12288 + col0) = acc[r];
    }
    __syncthreads();
    {
        _Float16* RW = (_Float16*)(ws + WS_RW); float* RB = (float*)(ws + WS_RB);
        for (int idx = blockIdx.x * NTHREADS + tid; idx < 2 * 48 * 2048; idx += gridDim.x * NTHREADS) {
            const int l = idx / (48 * 2048), rem = idx % (48 * 2048), col = rem >> 11, k = rem & 2047;
            float w = 0.f;
            if (col < 4) w = p.in[20][(size_t)l * 2048 * 4 + k * 4 + col]; else if (col < 36) w = p.in[22][(size_t)l * 2048 * 32 + k * 32 + (col - 4)];
            RW[idx] = (_Float16)w;
        }
        if (blockIdx.x == 0 && tid < 96) { const int l = tid / 48, col = tid % 48; float b = 0.f; if (col < 4) b = p.in[21][l * 4 + col]; else if (col < 36) b = p.in[23][l * 32 + col - 4]; RB[tid] = b; }
    }
    {
        LAS float* scr = (LAS float*)(lds + wave * 8704);
        constexpr int NITEMS = 32 * 224 + 32 * 64 + 32 * 192 + 32 * 64 + 64 * 3 * 512;
        const int n = gw < NITEMS ? (NITEMS - gw + NGW - 1) / NGW : 0;
        float tvA[32], tvB[32];
        TrItem iA = prologue_item(p, gw < NITEMS ? gw : NITEMS - 1), iB = iA; TRANSPOSE_LOAD(iA, tvA);
        int k = 0;
        for (; k + 2 < n; k += 2) {
            iB = prologue_item(p, gw + (k + 1) * NGW); TRANSPOSE_LOAD(iB, tvB); TRANSPOSE_STORE(iA, tvA);
            iA = prologue_item(p, gw + (k + 2) * NGW); TRANSPOSE_LOAD(iA, tvA); TRANSPOSE_STORE(iB, tvB);
        }
        { const int r1 = gw + (k + 1) * NGW; iB = prologue_item(p, r1 < NITEMS ? r1 : NITEMS - 1); TRANSPOSE_LOAD(iB, tvB); }
        if (k < n) TRANSPOSE_STORE(iA, tvA);
        if (k + 1 < n) TRANSPOSE_STORE(iB, tvB);
    }
}
__device__ __forceinline__ void phase_finalize(const Params& p) {
    unsigned char* ws = p.ws; const float* MP = (const float*)(ws + WS_MP); float* MOD = (float*)(ws + WS_MOD); float* LB = (float*)(ws + WS_LB);
    const int gt = blockIdx.x * NTHREADS + threadIdx.x, NT = gridDim.x * NTHREADS;
    for (int idx = gt; idx < 2 * 9 * 12288; idx += NT) {
        const int l = idx / (9 * 12288), rem = idx % (9 * 12288), r = rem / 12288, n = rem % 12288;
        float s = p.in[5][l * 12288 + n];
#pragma unroll
        for (int ks = 0; ks < 16; ++ks) s += MP[((size_t)((ks * 2 + l) * 9 + r)) * 12288 + n];
        MOD[idx] = s;
    }
    for (int idx = gt; idx < 2048; idx += NT) { const float r0 = p.in[11][idx], r1 = p.in[11][2048 + idx]; LB[idx] = 1.0f / (1.0f + __expf(r1 - r0)); }
}
__device__ __forceinline__ void norm_row_regs(f32x4 (&v)[8], const float* g, const float* sc, const float* sh, bf16_t* orow, int lane) {
    float s = 0.f;
#pragma unroll
    for (int j = 0; j < 8; ++j) s += (v[j].x * v[j].x + v[j].y * v[j].y) + (v[j].z * v[j].z + v[j].w * v[j].w);
    s = wave_sum(s);
    const float rinv = 1.0f / sqrtf(s * (1.0f / D) + EPS);
#pragma unroll
    for (int j = 0; j < 8; ++j) { const f32x4 gg = ((const f32x4*)g)[lane + 64 * j], cc = ((const f32x4*)sc)[lane + 64 * j], hh = ((const f32x4*)sh)[lane + 64 * j];
        const f32x4 h = v[j] * rinv * gg * (1.0f + cc) + hh;
        u32x2 w; w.x = cvt_pk_bf16(h.x, h.y); w.y = cvt_pk_bf16(h.z, h.w);
        ((u32x2*)orow)[lane + 64 * j] = w; }
}
__device__ __forceinline__ void phase_norm_mix0(const Params& p) {
    const int lane = threadIdx.x & 63, wave = __builtin_amdgcn_readfirstlane(threadIdx.x >> 6);
    const int gw = blockIdx.x * NWAVES + wave, NGW = gridDim.x * NWAVES;
    const float* MOD = (const float*)(p.ws + WS_MOD); bf16_t* HB = (bf16_t*)(p.ws + WS_HB);
    constexpr int NR = M + MC;
    const int n = gw < NR ? (NR - gw + NGW - 1) / NGW : 0;
#define NM_LOAD(v, r_) do { const int _r = (r_) < NR ? (r_) : NR - 1; const float* _x = _r < M ? p.in[0] + (size_t)_r * D : p.in[2] + (size_t)(_r - M) * D; \
        _Pragma("unroll") for (int j = 0; j < 8; ++j) v[j] = __builtin_nontemporal_load((const f32x4*)_x + lane + 64 * j); } while (0)
#define NM_STORE(v, r_) do { const int _r = (r_); const float* _md = MOD + (size_t)(_r < M ? _r / SEQ : 8) * 12288; norm_row_regs(v, p.in[6], _md + 2048, _md, HB + (size_t)_r * D, lane); } while (0)
    f32x4 va[8], vb[8];
    NM_LOAD(va, gw);
    int k = 0;
    for (; k + 2 < n; k += 2) {
        NM_LOAD(vb, gw + (k + 1) * NGW); NM_STORE(va, gw + k * NGW);
        NM_LOAD(va, gw + (k + 2) * NGW); NM_STORE(vb, gw + (k + 1) * NGW);
    }
    NM_LOAD(vb, gw + (k + 1) * NGW);
    if (k < n) NM_STORE(va, gw + k * NGW);
    if (k + 1 < n) NM_STORE(vb, gw + (k + 1) * NGW);
#undef NM_LOAD
#undef NM_STORE
}
__device__ __forceinline__ void phase_scan(const Params& p, LAS unsigned char* lds, int c) {
    const int tid = threadIdx.x, lane = tid & 63, w = __builtin_amdgcn_readfirstlane(tid >> 6), fr = lane & 15, fq = lane >> 4;
    const int b = c >> 5, h = (c >> 2) & 7, dir = (c >> 1) & 1, half = c & 1;
    unsigned char* ws = p.ws;
    const bf16_t* Q = (const bf16_t*)(ws + WS_Q);
    const _Float16* F = (const _Float16*)(ws + WS_Q + (size_t)(1 + dir) * PROJ_STRIDE);
    const bf16_t* V = (const bf16_t*)(ws + WS_Q + 3 * PROJ_STRIDE);
    const _Float16* CF = (const _Float16*)(ws + WS_CTXP + (size_t)dir * CTXP_STRIDE);
    const bf16_t* CV = (const bf16_t*)(ws + WS_CTXP + 2 * CTXP_STRIDE);
    bf16_t* O = (bf16_t*)(ws + (dir ? WS_OB : WS_OF));
    constexpr int QD_STRIDE = 272, KT_STRIDE = 144;
    constexpr int OFF_KET = 64 * QD_STRIDE, OFF_VT = OFF_KET + 128 * KT_STRIDE, OFF_PM = OFF_VT + 64 * KT_STRIDE, OFF_DEC = OFF_PM + 64 * KT_STRIDE, BUF_BYTES = OFF_DEC + 512;
    LAS unsigned char* KD = lds + 2 * BUF_BYTES;
    LAS float* TT = (LAS float*)(KD + 64 * QD_STRIDE);
    LAS unsigned char* QRAW = (LAS unsigned char*)(TT + 4 * 128);
    static_assert(2 * BUF_BYTES + 2 * 64 * QD_STRIDE + 4 * 128 * 4 <= MISC_OFF, "scan LDS");
#define SCAN_ROWBASE(t_, rb_, isctx_) const bool isctx_ = (t_) < 4; size_t rb_; { const int _n = isctx_ ? (t_) : (t_) - 4; const int _nch = isctx_ ? 4 : 64; const int _chn = dir ? _nch - 1 - _n : _n; \
        rb_ = (size_t)(b * 8 + h) * (isctx_ ? CL : SEQ) + (size_t)_chn * 64; }
    if (w >= 4) {
        const int pw = w - 4;
        const int k0 = 2 * lane; const int ppos = (k0 & ~31) + 8 * ((k0 >> 2) & 3) + 4 * ((k0 >> 4) & 1) + (k0 & 3);
        unsigned rfA[16], rfB[16], rfC[16];
#define SCAN_ISSUE_F(rf, t_) do { if ((t_) < 68) { SCAN_ROWBASE(t_, _rb, _isctx) \
        const unsigned* _pf = (const unsigned*)((_isctx ? CF : F) + (_rb + (dir ? 63 - 16 * pw : 16 * pw)) * 128 + k0); \
        if (dir) { _Pragma("unroll") for (int j = 0; j < 16; ++j) rf[j] = _pf[-64 * j]; } else { _Pragma("unroll") for (int j = 0; j < 16; ++j) rf[j] = _pf[64 * j]; } } } while (0)
#define SCAN_PRODUCE(rf, t_, ACT, ISSUE) do { const int t = (t_); constexpr bool act = (ACT); \
            LAS unsigned char* buf = lds + (t & 1) * BUF_BYTES; \
            if (act) { float a0 = 1.f, a1 = 1.f; \
                _Pragma("unroll") for (int j = 0; j < 16; ++j) { const unsigned wv = rf[j]; a0 *= (float)__builtin_bit_cast(_Float16, (unsigned short)(wv & 0xffffu)); a1 *= (float)__builtin_bit_cast(_Float16, (unsigned short)(wv >> 16)); } \
                *(LAS f32x2*)(TT + pw * 128 + k0) = (f32x2){a0, a1}; } \
            LDS_BARRIER();     \
            if (act) { \
                float eo0 = 1.f, eo1 = 1.f, el0 = 1.f, el1 = 1.f; \
                _Pragma("unroll") for (int ww = 0; ww < 4; ++ww) { const f32x2 tv = *(const LAS f32x2*)(TT + ww * 128 + k0); if (ww < pw) { eo0 *= tv.x; eo1 *= tv.y; } el0 *= tv.x; el1 *= tv.y; } \
                if (pw == 0) *(LAS f32x2*)(buf + OFF_DEC + 4 * k0) = (f32x2){el0, el1}; \
                unsigned ke[16]; \
                _Pragma("unroll") for (int j = 0; j < 16; ++j) { const int i = 16 * pw + j; \
                    const unsigned wv = rf[j]; const float f0 = (float)__builtin_bit_cast(_Float16, (unsigned short)(wv & 0xffffu)), f1 = (float)__builtin_bit_cast(_Float16, (unsigned short)(wv >> 16)); \
                    eo0 *= f0; eo1 *= f1; const float e0 = eo0, e1 = eo1; \
                    const float kd0 = (1.0f - f0) * __builtin_amdgcn_rcpf(e0), kd1 = (1.0f - f1) * __builtin_amdgcn_rcpf(e1); \
                    ke[j] = cvt_pk_bf16(kd0 * el0, kd1 * el1); \
                    const unsigned qw = *(const LAS unsigned*)(QRAW + i * QD_STRIDE + 2 * k0); \
                    *(LAS unsigned*)(buf + i * QD_STRIDE + 2 * ppos) = cvt_pk_bf16(bf_lo(qw) * e0, bf_hi(qw) * e1);     \
                    *(LAS unsigned*)(KD + i * QD_STRIDE + 2 * ppos) = cvt_pk_bf16(kd0, kd1); } \
                { u32x4 a, bb; \
                  _Pragma("unroll") for (int q = 0; q < 2; ++q) { \
                    a.x = (ke[8 * q + 0] & 0xffffu) | (ke[8 * q + 1] << 16); a.y = (ke[8 * q + 2] & 0xffffu) | (ke[8 * q + 3] << 16); a.z = (ke[8 * q + 4] & 0xffffu) | (ke[8 * q + 5] << 16); a.w = (ke[8 * q + 6] & 0xffffu) | (ke[8 * q + 7] << 16); \
                    bb.x = (ke[8 * q + 0] >> 16) | (ke[8 * q + 1] & 0xffff0000u); bb.y = (ke[8 * q + 2] >> 16) | (ke[8 * q + 3] & 0xffff0000u); bb.z = (ke[8 * q + 4] >> 16) | (ke[8 * q + 5] & 0xffff0000u); bb.w = (ke[8 * q + 6] >> 16) | (ke[8 * q + 7] & 0xffff0000u); \
                    *(LAS u32x4*)(buf + OFF_KET + (k0 + 0) * KT_STRIDE + 32 * pw + 16 * q) = a; *(LAS u32x4*)(buf + OFF_KET + (k0 + 1) * KT_STRIDE + 32 * pw + 16 * q) = bb; } } \
                if (ISSUE) SCAN_ISSUE_F(rf, t + 3); \
            } \
            LDS_BARRIER();     \
            LDS_BARRIER();     \
        } while (0)
        SCAN_ISSUE_F(rfA, 0); SCAN_ISSUE_F(rfB, 1); SCAN_ISSUE_F(rfC, 2);
        for (int t3 = 0; t3 < 63; t3 += 3) {
            SCAN_PRODUCE(rfA, t3, true, true);
            SCAN_PRODUCE(rfB, t3 + 1, true, true);
            SCAN_PRODUCE(rfC, t3 + 2, true, true);
        }
        SCAN_PRODUCE(rfA, 63, true, true); SCAN_PRODUCE(rfB, 64, true, true); SCAN_PRODUCE(rfC, 65, true, false);
        SCAN_PRODUCE(rfA, 66, true, false); SCAN_PRODUCE(rfB, 67, true, false); SCAN_PRODUCE(rfC, 68, false, false);
        SCAN_PRODUCE(rfA, 69, false, false); SCAN_PRODUCE(rfB, 70, false, false); SCAN_PRODUCE(rfC, 71, false, false);
#undef SCAN_PRODUCE
#undef SCAN_ISSUE_F
    } else {
        f32x4 S[8];
#pragma unroll
        for (int tk = 0; tk < 8; ++tk) S[tk] = (f32x4){0.f, 0.f, 0.f, 0.f};
        const int k0 = 2 * lane, vp = lane & 31, vh = lane >> 5, chv = 64 * half + 2 * vp;
        unsigned rqA[16], rvA[8], rqB[16], rvB[8];
#define SCAN_ISSUE_QV(rq, rv, t_) do { if ((t_) < 68) { SCAN_ROWBASE(t_, _rb, _isctx) \
        const unsigned* _pq = (const unsigned*)(Q + (_rb + (dir ? 63 - 16 * w : 16 * w)) * 128 + k0); \
        const unsigned* _pv = (const unsigned*)((_isctx ? CV : V) + (_rb + (dir ? 63 - 16 * w - 8 * vh : 16 * w + 8 * vh)) * 128 + chv); \
        if (dir) { _Pragma("unroll") for (int j = 0; j < 16; ++j) rq[j] = _pq[-64 * j]; _Pragma("unroll") for (int j = 0; j < 8; ++j) rv[j] = _pv[-64 * j]; } \
        else     { _Pragma("unroll") for (int j = 0; j < 16; ++j) rq[j] = _pq[64 * j];  _Pragma("unroll") for (int j = 0; j < 8; ++j) rv[j] = _pv[64 * j]; } } } while (0)
#define SCAN_CONSUME(rq, rv, s_, RUN, LAT, NXT, ISSUE, PNEXT) do { const int s = (s_); constexpr bool run = (RUN), lat = (LAT), nxt = (NXT); \
            LAS unsigned char* buf = lds + (s & 1) * BUF_BYTES; \
            LAS unsigned char* nbuf = lds + ((s + 1) & 1) * BUF_BYTES; \
              \
            bf16x8 qfa[4][4]; \
            if (lat) { \
                _Pragma("unroll") for (int tt = 0; tt < 4; ++tt) \
                    _Pragma("unroll") for (int g = 0; g < 4; ++g) qfa[tt][g] = *(const LAS bf16x8*)(buf + (16 * tt + fr) * QD_STRIDE + 2 * (32 * g + 8 * fq)); \
            } \
            if (nxt) {     \
                _Pragma("unroll") for (int j = 0; j < 16; ++j) *(LAS unsigned*)(QRAW + (16 * w + j) * QD_STRIDE + 2 * k0) = rq[j]; \
                u32x4 a, bb; \
                a.x = (rv[0] & 0xffffu) | (rv[1] << 16); a.y = (rv[2] & 0xffffu) | (rv[3] << 16); a.z = (rv[4] & 0xffffu) | (rv[5] << 16); a.w = (rv[6] & 0xffffu) | (rv[7] << 16); \
                bb.x = (rv[0] >> 16) | (rv[1] & 0xffff0000u); bb.y = (rv[2] >> 16) | (rv[3] & 0xffff0000u); bb.z = (rv[4] >> 16) | (rv[5] & 0xffff0000u); bb.w = (rv[6] >> 16) | (rv[7] & 0xffff0000u); \
                *(LAS u32x4*)(nbuf + OFF_VT + (2 * vp + 0) * KT_STRIDE + 32 * w + 16 * vh) = a; *(LAS u32x4*)(nbuf + OFF_VT + (2 * vp + 1) * KT_STRIDE + 32 * w + 16 * vh) = bb; \
                if (ISSUE) SCAN_ISSUE_QV(rq, rv, s + 3); } \
            f32x4 o[4]; \
            _Pragma("unroll") for (int tt = 0; tt < 4; ++tt) o[tt] = (f32x4){0.f, 0.f, 0.f, 0.f}; \
            if (lat) {     \
                bf16x8 sf[4]; \
                _Pragma("unroll") for (int g = 0; g < 4; ++g) { u32x4 t4; t4.x = cvt_pk_bf16(S[2 * g][0], S[2 * g][1]); t4.y = cvt_pk_bf16(S[2 * g][2], S[2 * g][3]); t4.z = cvt_pk_bf16(S[2 * g + 1][0], S[2 * g + 1][1]); t4.w = cvt_pk_bf16(S[2 * g + 1][2], S[2 * g + 1][3]); \
                    sf[g] = __builtin_bit_cast(bf16x8, t4); } \
                LDS_WAIT(); \
                _Pragma("unroll") for (int tt = 0; tt < 4; ++tt) \
                    _Pragma("unroll") for (int g = 0; g < 4; ++g) o[tt] = __builtin_amdgcn_mfma_f32_16x16x32_bf16(sf[g], qfa[tt][g], o[tt], 0, 0, 0); \
            } \
            LDS_BARRIER();     \
            bf16x8 vf[2], pfa[4][2], kfa[4][2], kfb[4][2]; f32x4 d4a[4], d4b[4]; \
            if (run) { _Pragma("unroll") for (int z = 0; z < 2; ++z) vf[z] = *(const LAS bf16x8*)(buf + OFF_VT + (16 * w + fr) * KT_STRIDE + 2 * (32 * z + 8 * fq)); } \
            if (lat) { _Pragma("unroll") for (int tt = 0; tt < 4; ++tt) _Pragma("unroll") for (int z = 0; z < 2; ++z) pfa[tt][z] = *(const LAS bf16x8*)(buf + OFF_PM + (16 * tt + fr) * KT_STRIDE + 2 * (32 * z + 8 * fq)); } \
            LDS_WAIT(); \
            if (run) {     \
                _Pragma("unroll") for (int tk = 0; tk < 4; ++tk) { d4a[tk] = *(const LAS f32x4*)(buf + OFF_DEC + 4 * (16 * tk + 4 * fq)); \
                    _Pragma("unroll") for (int z = 0; z < 2; ++z) kfa[tk][z] = *(const LAS bf16x8*)(buf + OFF_KET + (16 * tk + fr) * KT_STRIDE + 2 * (32 * z + 8 * fq)); } } \
            if (lat) {     \
                SCAN_ROWBASE(s, rb, isctx_unused) \
                (void)isctx_unused; \
                _Pragma("unroll") for (int tt = 0; tt < 4; ++tt) { \
                    _Pragma("unroll") for (int z = 0; z < 2; ++z) o[tt] = __builtin_amdgcn_mfma_f32_16x16x32_bf16(vf[z], pfa[tt][z], o[tt], 0, 0, 0); } \
                _Pragma("unroll") for (int tt = 0; tt < 4; ++tt) { \
                    const int i = 16 * tt + fr; const size_t row = rb + (dir ? 63 - i : i); \
                    u32x2 wv; wv.x = cvt_pk_bf16(o[tt][0], o[tt][1]); wv.y = cvt_pk_bf16(o[tt][2], o[tt][3]); \
                    *(u32x2*)(O + row * 128 + 64 * half + 16 * w + 4 * fq) = wv; } \
            } \
            if (run) {     \
                LDS_WAIT(); \
                _Pragma("unroll") for (int tk = 0; tk < 4; ++tk) { d4b[tk] = *(const LAS f32x4*)(buf + OFF_DEC + 4 * (16 * (tk + 4) + 4 * fq)); \
                    _Pragma("unroll") for (int z = 0; z < 2; ++z) kfb[tk][z] = *(const LAS bf16x8*)(buf + OFF_KET + (16 * (tk + 4) + fr) * KT_STRIDE + 2 * (32 * z + 8 * fq)); } \
                _Pragma("unroll") for (int tk = 0; tk < 4; ++tk) { \
                    f32x4 a = S[tk] * d4a[tk]; \
                    _Pragma("unroll") for (int z = 0; z < 2; ++z) a = __builtin_amdgcn_mfma_f32_16x16x32_bf16(kfa[tk][z], vf[z], a, 0, 0, 0); \
                    S[tk] = a; } \
                LDS_WAIT(); \
                _Pragma("unroll") for (int tk = 0; tk < 4; ++tk) { \
                    f32x4 a = S[tk + 4] * d4b[tk]; \
                    _Pragma("unroll") for (int z = 0; z < 2; ++z) a = __builtin_amdgcn_mfma_f32_16x16x32_bf16(kfb[tk][z], vf[z], a, 0, 0, 0); \
                    S[tk + 4] = a; } \
            } \
            LDS_BARRIER();     \
            if (PNEXT) {     \
                const int tt = w; \
                bf16x8 qf[4], kfp[4][4]; \
                _Pragma("unroll") for (int g = 0; g < 4; ++g) qf[g] = *(const LAS bf16x8*)(nbuf + (16 * tt + fr) * QD_STRIDE + 2 * (32 * g + 8 * fq)); \
                _Pragma("unroll") for (int ts = 0; ts < 4; ++ts) \
                    _Pragma("unroll") for (int g = 0; g < 4; ++g) kfp[ts][g] = *(const LAS bf16x8*)(KD + (16 * ts + fr) * QD_STRIDE + 2 * (32 * g + 8 * fq)); \
                LDS_WAIT(); \
                _Pragma("unroll") for (int ts = 0; ts < 4; ++ts) { \
                    const int ii = 16 * tt + fr, ip0 = 16 * ts + 4 * fq; \
                    u32x2 wv = (u32x2){0u, 0u}; \
                    if (ts <= tt) { \
                        f32x4 pc = (f32x4){0.f, 0.f, 0.f, 0.f}; \
                        _Pragma("unroll") for (int g = 0; g < 4; ++g) pc = __builtin_amdgcn_mfma_f32_16x16x32_bf16(kfp[ts][g], qf[g], pc, 0, 0, 0); \
                        f32x4 pm; \
                        _Pragma("unroll") for (int j = 0; j < 4; ++j) pm[j] = (ip0 + j <= ii) ? pc[j] : 0.f; \
                        wv.x = cvt_pk_bf16(pm[0], pm[1]); wv.y = cvt_pk_bf16(pm[2], pm[3]); } \
                    *(LAS u32x2*)(nbuf + OFF_PM + ii * KT_STRIDE + 2 * ip0) = wv; } \
            } \
            LDS_BARRIER();     \
        } while (0)
        SCAN_ISSUE_QV(rqA, rvA, 0); SCAN_ISSUE_QV(rqB, rvB, 1);
        SCAN_CONSUME(rqA, rvA, -1, false, false, true, true, false);
        SCAN_CONSUME(rqB, rvB, 0, true, false, true, true, false); SCAN_CONSUME(rqA, rvA, 1, true, false, true, true, false);
        SCAN_CONSUME(rqB, rvB, 2, true, false, true, true, false); SCAN_CONSUME(rqA, rvA, 3, true, false, true, true, true);
        for (int s2 = 4; s2 < 64; s2 += 2) {
            SCAN_CONSUME(rqB, rvB, s2, true, true, true, true, true);
            SCAN_CONSUME(rqA, rvA, s2 + 1, true, true, true, true, true);
        }
        SCAN_CONSUME(rqB, rvB, 64, true, true, true, true, true); SCAN_CONSUME(rqA, rvA, 65, true, true, true, false, true);
        SCAN_CONSUME(rqB, rvB, 66, true, true, true, false, true); SCAN_CONSUME(rqA, rvA, 67, true, true, false, false, false);
        SCAN_CONSUME(rqB, rvB, 68, false, false, false, false, false); SCAN_CONSUME(rqA, rvA, 69, false, false, false, false, false); SCAN_CONSUME(rqB, rvB, 70, false, false, false, false, false);
#undef SCAN_CONSUME
#undef SCAN_ISSUE_QV
    }
#undef SCAN_ROWBASE
}
__device__ __forceinline__ void phase_gmlp(const Params& p, LAS unsigned char* lds, int unit) {
    const int tid = threadIdx.x, lane = tid & 63, w = __builtin_amdgcn_readfirstlane(tid >> 6), fr = lane & 15, fq = lane >> 4;
    unsigned char* ws = p.ws;
    const bf16_t* U = (const bf16_t*)(ws + WS_Q + 5 * PROJ_STRIDE); const bf16_t* VG = (const bf16_t*)(ws + WS_Q + 6 * PROJ_STRIDE);
    bf16_t* A2 = (bf16_t*)(ws + WS_HB);
    const float* ln_g = p.in[13]; const float* ln_b = p.in[14]; const float* w_s = p.in[15]; const float* b_s = p.in[16];
    constexpr int TS = 272;
    LAS unsigned char* VNT = lds;
    LAS unsigned char* WS_ = lds + 128 * TS;
    LAS float* MU = (LAS float*)(lds + 2 * 128 * TS); LAS float* RS = MU + 128;
    const size_t row0 = (size_t)unit * 128;
    __syncthreads();
#pragma unroll
    for (int hf = 0; hf < 2; ++hf) {
        u32x4 xa[8][2];
#pragma unroll
        for (int rr = 0; rr < 8; ++rr) { const u32x4* src = (const u32x4*)(VG + (row0 + 16 * w + 8 * hf + rr) * 1024 + 16 * lane); xa[rr][0] = src[0]; xa[rr][1] = src[1]; }
        float sm[8], sq[8];
#pragma unroll
        for (int rr = 0; rr < 8; ++rr) { float s1 = 0.f, s2 = 0.f;
#pragma unroll
            for (int q = 0; q < 2; ++q) { const unsigned ww[4] = {xa[rr][q].x, xa[rr][q].y, xa[rr][q].z, xa[rr][q].w};
#pragma unroll
                for (int j = 0; j < 4; ++j) { const float a = bf_lo(ww[j]), c = bf_hi(ww[j]); s1 += a + c; s2 += a * a + c * c; } }
            sm[rr] = s1; sq[rr] = s2; }
#pragma unroll
        for (int o = 1; o < 64; o <<= 1) {
#pragma unroll
            for (int rr = 0; rr < 8; ++rr) { sm[rr] += __shfl_xor(sm[rr], o); sq[rr] += __shfl_xor(sq[rr], o); } }
        if (lane < 8) { float m = 0.f, q2 = 0.f;
#pragma unroll
            for (int rr = 0; rr < 8; ++rr) { m = (lane == rr) ? sm[rr] : m; q2 = (lane == rr) ? sq[rr] : q2; }
            const float mean = m * (1.0f / 1024.0f); const float var = fmaxf(q2 * (1.0f / 1024.0f) - mean * mean, 0.f);
            MU[16 * w + 8 * hf + lane] = mean; RS[16 * w + 8 * hf + lane] = 1.0f / sqrtf(var + EPS); }
    }
    unsigned vr[16]; f32x4 wr4[8];
#define GMLP_LOAD(g_) do { const int _d0 = 2 * lane; \
        _Pragma("unroll") for (int j = 0; j < 16; ++j) vr[j] = *(const unsigned*)(VG + (row0 + 16 * w + j) * 1024 + (g_) * 128 + _d0); \
        const f32x4* _src = (const f32x4*)(w_s + ((size_t)(g_) * 128 + (tid >> 2)) * 128 + (tid & 3) * 32); \
        _Pragma("unroll") for (int q4 = 0; q4 < 8; ++q4) wr4[q4] = _src[q4]; } while (0)
    GMLP_LOAD(0);
    __syncthreads();
#define GMLP_GROUP(g_, PREFETCH) do { const int g = (g_); \
        { const int d0 = 2 * lane; const float g0 = ln_g[g * 128 + d0], g1 = ln_g[g * 128 + d0 + 1], b0 = ln_b[g * 128 + d0], b1 = ln_b[g * 128 + d0 + 1]; \
          unsigned pk[16]; \
        _Pragma("unroll") \
          for (int j = 0; j < 16; ++j) { const int sidx = 16 * w + j; const unsigned wv = vr[j]; const float mu = MU[sidx], rs = RS[sidx]; \
              pk[j] = cvt_pk_bf16((bf_lo(wv) - mu) * rs * g0 + b0, (bf_hi(wv) - mu) * rs * g1 + b1); } \
          u32x4 a, bb, c2, d2; \
          a.x = (pk[0] & 0xffffu) | (pk[1] << 16); a.y = (pk[2] & 0xffffu) | (pk[3] << 16); a.z = (pk[4] & 0xffffu) | (pk[5] << 16); a.w = (pk[6] & 0xffffu) | (pk[7] << 16); \
          bb.x = (pk[8] & 0xffffu) | (pk[9] << 16); bb.y = (pk[10] & 0xffffu) | (pk[11] << 16); bb.z = (pk[12] & 0xffffu) | (pk[13] << 16); bb.w = (pk[14] & 0xffffu) | (pk[15] << 16); \
          c2.x = (pk[0] >> 16) | (pk[1] & 0xffff0000u); c2.y = (pk[2] >> 16) | (pk[3] & 0xffff0000u); c2.z = (pk[4] >> 16) | (pk[5] & 0xffff0000u); c2.w = (pk[6] >> 16) | (pk[7] & 0xffff0000u); \
          d2.x = (pk[8] >> 16) | (pk[9] & 0xffff0000u); d2.y = (pk[10] >> 16) | (pk[11] & 0xffff0000u); d2.z = (pk[12] >> 16) | (pk[13] & 0xffff0000u); d2.w = (pk[14] >> 16) | (pk[15] & 0xffff0000u); \
          *(LAS u32x4*)(VNT + (d0 + 0) * TS + 32 * w) = a; *(LAS u32x4*)(VNT + (d0 + 0) * TS + 32 * w + 16) = bb; \
          *(LAS u32x4*)(VNT + (d0 + 1) * TS + 32 * w) = c2; *(LAS u32x4*)(VNT + (d0 + 1) * TS + 32 * w + 16) = d2; } \
        { const int t = tid >> 2, s0 = (tid & 3) * 32; \
        _Pragma("unroll") \
          for (int q4 = 0; q4 < 4; ++q4) { const f32x4 x0 = wr4[2 * q4], x1 = wr4[2 * q4 + 1]; u32x4 o; o.x = cvt_pk_bf16(x0.x, x0.y); o.y = cvt_pk_bf16(x0.z, x0.w); o.z = cvt_pk_bf16(x1.x, x1.y); o.w = cvt_pk_bf16(x1.z, x1.w); \
              *(LAS u32x4*)(WS_ + t * TS + 2 * s0 + 16 * q4) = o; } } \
        u32x2 uv[8]; float bsv[8]; \
        _Pragma("unroll") \
        for (int tt = 0; tt < 8; ++tt) { const int t = 16 * tt + fr; uv[tt] = *(const u32x2*)(U + (row0 + t) * 1024 + g * 128 + 16 * w + 4 * fq); bsv[tt] = b_s[g * 128 + t]; } \
        if (PREFETCH) GMLP_LOAD(g + 1); \
        LDS_BARRIER(); \
        bf16x8 af[4]; \
        _Pragma("unroll") \
        for (int ks = 0; ks < 4; ++ks) af[ks] = *(const LAS bf16x8*)(VNT + (16 * w + fr) * TS + 2 * (32 * ks + 8 * fq)); \
        _Pragma("unroll") \
        for (int tt = 0; tt < 8; ++tt) { \
            f32x4 a = (f32x4){0.f, 0.f, 0.f, 0.f}; \
        _Pragma("unroll") \
            for (int ks = 0; ks < 4; ++ks) { const bf16x8 bfr = *(const LAS bf16x8*)(WS_ + (16 * tt + fr) * TS + 2 * (32 * ks + 8 * fq)); a = __builtin_amdgcn_mfma_f32_16x16x32_bf16(af[ks], bfr, a, 0, 0, 0); } \
            const int t = 16 * tt + fr; const float bs = bsv[tt]; \
            u32x2 o; o.x = cvt_pk_bf16(bf_lo(uv[tt].x) * (a[0] + bs), bf_hi(uv[tt].x) * (a[1] + bs)); o.y = cvt_pk_bf16(bf_lo(uv[tt].y) * (a[2] + bs), bf_hi(uv[tt].y) * (a[3] + bs)); \
            *(u32x2*)(A2 + (row0 + t) * 2048 + 1024 + g * 128 + 16 * w + 4 * fq) = o; \
        } \
        LDS_BARRIER(); \
    } while (0)
    for (int gg = 0; gg < 7; ++gg) GMLP_GROUP(gg, true);
    GMLP_GROUP(7, false);
#undef GMLP_GROUP
#undef GMLP_LOAD
}
__device__ __forceinline__ void phase_hgrn_out(const Params& p) {
    const int lane = threadIdx.x & 63, wave = __builtin_amdgcn_readfirstlane(threadIdx.x >> 6);
    const int gw = blockIdx.x * NWAVES + wave, NGW = gridDim.x * NWAVES;
    unsigned char* ws = p.ws;
    const bf16_t* OF = (const bf16_t*)(ws + WS_OF); const bf16_t* OB = (const bf16_t*)(ws + WS_OB); const bf16_t* G = (const bf16_t*)(ws + WS_Q + 4 * PROJ_STRIDE);
    bf16_t* A2 = (bf16_t*)(ws + WS_HB); const float* ng = p.in[12];
    f32x4 gn[4];
#pragma unroll
    for (int j = 0; j < 4; ++j) gn[j] = ((const f32x4*)(ng + 16 * lane))[j];
    const int n = gw < M ? (M - gw + NGW - 1) / NGW : 0;
    u32x4 fa[2], ba[2], ga[2], fb[2], bb[2], gb[2];
#define HO_LOAD(f_, b_, g_, r_) do { const int _r = (r_) < M ? (r_) : M - 1; \
        const size_t _ohm = ((size_t)((_r / SEQ) * 8 + (lane >> 3)) * SEQ + (_r % SEQ)) * 128 + 16 * (lane & 7);     \
        const u32x4* _pf = (const u32x4*)(OF + _ohm); const u32x4* _pb = (const u32x4*)(OB + _ohm); const u32x4* _pg = (const u32x4*)(G + (size_t)_r * 1024 + 16 * lane); \
        f_[0] = _pf[0]; f_[1] = _pf[1]; b_[0] = _pb[0]; b_[1] = _pb[1]; g_[0] = _pg[0]; g_[1] = _pg[1]; } while (0)
#define HO_STORE(f_, b_, g_, r_) do { const int r = (r_); float o[16]; float ss = 0.f; unsigned gg[8]; \
        _Pragma("unroll") for (int q = 0; q < 2; ++q) { const unsigned aw[4] = {f_[q].x, f_[q].y, f_[q].z, f_[q].w}, bw[4] = {b_[q].x, b_[q].y, b_[q].z, b_[q].w}, gw4[4] = {g_[q].x, g_[q].y, g_[q].z, g_[q].w}; \
            _Pragma("unroll") for (int j = 0; j < 4; ++j) { o[8 * q + 2 * j] = bf_lo(aw[j]) + bf_lo(bw[j]); o[8 * q + 2 * j + 1] = bf_hi(aw[j]) + bf_hi(bw[j]); gg[4 * q + j] = gw4[j]; } } \
        _Pragma("unroll") for (int j = 0; j < 16; ++j) ss += o[j] * o[j]; \
        ss += __shfl_xor(ss, 1); ss += __shfl_xor(ss, 2); ss += __shfl_xor(ss, 4); \
        const float rinv = 1.0f / sqrtf(ss * (1.0f / 128.0f) + EPS); \
        unsigned ow[8]; \
        _Pragma("unroll") for (int j = 0; j < 8; ++j) { const float g0 = gn[j >> 1][(2 * j) & 3], g1 = gn[j >> 1][(2 * j + 1) & 3]; \
            ow[j] = cvt_pk_bf16(o[2 * j] * rinv * g0 * bf_lo(gg[j]), o[2 * j + 1] * rinv * g1 * bf_hi(gg[j])); } \
        u32x4* dst = (u32x4*)(A2 + (size_t)r * 2048 + 16 * lane); \
        dst[0] = (u32x4){ow[0], ow[1], ow[2], ow[3]}; dst[1] = (u32x4){ow[4], ow[5], ow[6], ow[7]}; } while (0)
    HO_LOAD(fa, ba, ga, gw);
    int k = 0;
    for (; k + 2 < n; k += 2) {
        HO_LOAD(fb, bb, gb, gw + (k + 1) * NGW); HO_STORE(fa, ba, ga, gw + k * NGW);
        HO_LOAD(fa, ba, ga, gw + (k + 2) * NGW); HO_STORE(fb, bb, gb, gw + (k + 1) * NGW);
    }
    HO_LOAD(fb, bb, gb, gw + (k + 1) * NGW);
    if (k < n) HO_STORE(fa, ba, ga, gw + k * NGW);
    if (k + 1 < n) HO_STORE(fb, bb, gb, gw + (k + 1) * NGW);
#undef HO_LOAD
#undef HO_STORE
}
typedef _Float16 f16x8 __attribute__((ext_vector_type(8)));
typedef _Float16 f16x2 __attribute__((ext_vector_type(2)));
__device__ __forceinline__ unsigned cvt_pk_f16(float lo, float hi) { const f32x2 v = {lo, hi}; return __builtin_bit_cast(unsigned, __builtin_convertvector(v, f16x2)); }
__device__ __forceinline__ void phase_router(const Params& p, LAS unsigned char* lds, int l) {
    const int tid = threadIdx.x, lane = tid & 63, w = __builtin_amdgcn_readfirstlane(tid >> 6), fr = lane & 15, fq = lane >> 4;
    unsigned char* ws = p.ws;
    const bf16_t* X = (const bf16_t*)(ws + WS_XB); bf16_t* HB = (bf16_t*)(ws + WS_HB);
    const float* MOD = (const float*)(ws + WS_MOD) + (size_t)l * 9 * 12288;
    const _Float16* RW = (const _Float16*)(ws + WS_RW) + (size_t)l * 48 * 2048;
    const float* RB = (const float*)(ws + WS_RB) + l * 48; const float* gnorm = p.in[7] + (size_t)l * D;
    int* ASG_E = (int*)(ws + RT_ASG_E); int* ASG_R = (int*)(ws + RT_ASG_R); float* ASG_W = (float*)(ws + RT_ASG_W); int* CNT = (int*)(ws + RT_CNT);
    LAS float* GS = (LAS float*)lds;
    LAS float* SH = GS + 2048;
    LAS float* SSQ = SH + 2048;
    LAS float* PL = SSQ + 256;
    LAS float* LG = PL + 2 * 8 * 16 * 48;
    LAS int* T_E = (LAS int*)(LG + 128 * 48);
    LAS float* T_W = (LAS float*)(T_E + 256);
    LAS int* T_R = (LAS int*)(T_W + 256);
    f16x8 bw[8][3];
#pragma unroll
    for (int ks = 0; ks < 8; ++ks)
#pragma unroll
        for (int ct = 0; ct < 3; ++ct) bw[ks][ct] = *(const f16x8*)(RW + (size_t)(16 * ct + fr) * 2048 + 256 * w + 32 * ks + 8 * fq);
    for (int tile = blockIdx.x; tile < M / 128; tile += gridDim.x) {
        const int b = (tile * 128) / SEQ; const float* md = MOD + (size_t)b * 12288;
        __syncthreads();
        for (int k = tid; k < 2048; k += NTHREADS) { GS[k] = gnorm[k] * (1.0f + md[4 * 2048 + k]); SH[k] = md[3 * 2048 + k]; }
        u32x4 xw[8];
#define ROUTER_LOAD(grp_) do { const bf16_t* _src = X + ((size_t)tile * 128 + (grp_) * 16 + fr) * D + 256 * w + 8 * fq; \
        _Pragma("unroll") for (int ks = 0; ks < 8; ++ks) xw[ks] = *(const u32x4*)(_src + 32 * ks); } while (0)
        ROUTER_LOAD(0);
        __syncthreads();
#define ROUTER_GROUP(grp_, PREFETCH) do { const int grp = (grp_); \
            const size_t rbase = (size_t)tile * 128 + grp * 16; \
            LAS float* ssq = SSQ + (grp & 1) * 128; LAS float* pl = PL + (grp & 1) * (8 * 16 * 48); \
            float ss = 0.f; \
            _Pragma("unroll") \
            for (int ks = 0; ks < 8; ++ks) { const u32x4 t4 = xw[ks]; const unsigned tw[4] = {t4.x, t4.y, t4.z, t4.w}; \
            _Pragma("unroll") \
                for (int q = 0; q < 4; ++q) { const float a = bf_lo(tw[q]), c = bf_hi(tw[q]); ss += a * a + c * c; } } \
            ss += __shfl_xor(ss, 16); ss += __shfl_xor(ss, 32); \
            if (fq == 0) ssq[w * 16 + fr] = ss; \
            LDS_BARRIER(); \
            float tot = 0.f; \
            _Pragma("unroll") \
            for (int ww = 0; ww < 8; ++ww) tot += ssq[ww * 16 + fr]; \
            const float rinv = 1.0f / sqrtf(tot * (1.0f / D) + EPS); \
            f32x4 acc[3]; \
            _Pragma("unroll") \
            for (int ct = 0; ct < 3; ++ct) acc[ct] = (f32x4){0.f, 0.f, 0.f, 0.f}; \
            _Pragma("unroll") \
            for (int ks = 0; ks < 8; ++ks) { \
                const int kk = 256 * w + 32 * ks + 8 * fq; \
                float hv[8]; \
            _Pragma("unroll") \
                for (int q = 0; q < 2; ++q) { const f32x4 gs = *(const LAS f32x4*)(GS + kk + 4 * q), sh = *(const LAS f32x4*)(SH + kk + 4 * q); \
                    const unsigned x01 = q ? xw[ks].z : xw[ks].x, x23 = q ? xw[ks].w : xw[ks].y; const f32x4 xq = (f32x4){bf_lo(x01), bf_hi(x01), bf_lo(x23), bf_hi(x23)}; \
                    const f32x4 hh = xq * rinv * gs + sh; \
                    hv[4 * q] = hh.x; hv[4 * q + 1] = hh.y; hv[4 * q + 2] = hh.z; hv[4 * q + 3] = hh.w; } \
                u32x4 hi, hf; \
                hi.x = cvt_pk_bf16(hv[0], hv[1]); hi.y = cvt_pk_bf16(hv[2], hv[3]); hi.z = cvt_pk_bf16(hv[4], hv[5]); hi.w = cvt_pk_bf16(hv[6], hv[7]); \
                hf.x = cvt_pk_f16(hv[0], hv[1]); hf.y = cvt_pk_f16(hv[2], hv[3]); hf.z = cvt_pk_f16(hv[4], hv[5]); hf.w = cvt_pk_f16(hv[6], hv[7]); \
                *(u32x4*)(HB + (rbase + fr) * D + kk) = hi; \
                const f16x8 ah = __builtin_bit_cast(f16x8, hf); \
            _Pragma("unroll") \
                for (int ct = 0; ct < 3; ++ct) acc[ct] = __builtin_amdgcn_mfma_f32_16x16x32_f16(ah, bw[ks][ct], acc[ct], 0, 0, 0); \
                asm volatile("" ::: "memory"); \
            } \
            if (PREFETCH) ROUTER_LOAD(grp + 1);   \
            _Pragma("unroll") \
            for (int ct = 0; ct < 3; ++ct) \
            _Pragma("unroll") \
                for (int j = 0; j < 4; ++j) pl[(w * 16 + 4 * fq + j) * 48 + 16 * ct + fr] = acc[ct][j]; \
            LDS_BARRIER(); \
            for (int idx = tid; idx < 16 * 48; idx += NTHREADS) { float sred = 0.f; \
            _Pragma("unroll") \
                for (int ww = 0; ww < 8; ++ww) sred += pl[ww * 768 + idx]; \
                LG[grp * 768 + idx] = sred; } \
        } while (0)
        for (int gq = 0; gq < 7; ++gq) ROUTER_GROUP(gq, true);
        ROUTER_GROUP(7, false);
#undef ROUTER_GROUP
#undef ROUTER_LOAD
        __syncthreads();
        if (tid < 128) {
            float lg[4];
#pragma unroll
            for (int c2 = 0; c2 < 4; ++c2) lg[c2] = RB[c2] + LG[tid * 48 + c2];
            int gi = 0; float gm = lg[0];
#pragma unroll
            for (int q = 1; q < 4; ++q) if (lg[q] > gm) { gm = lg[q]; gi = q; }
            float gsum = 0.f;
#pragma unroll
            for (int q = 0; q < 4; ++q) gsum += __expf(lg[q] - gm);
            const float ptop = 1.0f / gsum;
            float le[8];
#pragma unroll
            for (int q = 0; q < 8; ++q) le[q] = RB[4 + 8 * gi + q] + LG[tid * 48 + 4 + 8 * gi + q];
            int i0 = 0; float m0 = le[0];
#pragma unroll
            for (int q = 1; q < 8; ++q) if (le[q] > m0) { m0 = le[q]; i0 = q; }
            int i1 = -1; float m1 = -3.0e38f;
#pragma unroll
            for (int q = 0; q < 8; ++q) if (q != i0 && le[q] > m1) { m1 = le[q]; i1 = q; }
            if (i1 < 0) { i1 = (i0 + 1) & 7; m1 = m0; }
            float e1 = __expf(m1 - m0);
            if (!(e1 <= 1.0f)) e1 = 1.0f;
            const float w0 = ptop / (1.0f + e1), w1 = ptop * e1 / (1.0f + e1);
            const int a0 = tid * 2;
            T_E[a0] = gi * 8 + i0; T_E[a0 + 1] = gi * 8 + i1; T_W[a0] = w0; T_W[a0 + 1] = w1;
        }
        __syncthreads();
        if (tid < 32) { int cnt = 0; for (int a = 0; a < 256; ++a) { if (T_E[a] == tid) { T_R[a] = cnt; ++cnt; } } CNT[tile * 32 + tid] = cnt; }
        __syncthreads();
        if (tid < 256) { ASG_E[tile * 256 + tid] = T_E[tid]; ASG_R[tile * 256 + tid] = T_R[tid]; ASG_W[tile * 256 + tid] = T_W[tid]; }
    }
}
__device__ __forceinline__ void moe_tables(const Params& p, LAS int* OFFS, LAS int* TOT, LAS int* TILE_E, LAS int* PART) {
    const int tid = threadIdx.x; const int* CNT = (const int*)(p.ws + RT_CNT); const int e = tid & 31, part = tid >> 5;
    int v[16];
#pragma unroll
    for (int j = 0; j < 16; ++j) v[j] = CNT[(part * 16 + j) * 32 + e];
    int sp = 0;
#pragma unroll
    for (int j = 0; j < 16; ++j) sp += v[j];
    PART[part * 32 + e] = sp;
    __syncthreads();
    if (tid < 32) { int t = 0;
#pragma unroll
        for (int q = 0; q < 16; ++q) t += PART[q * 32 + tid];
        TOT[tid] = t; }
    __syncthreads();
    if (tid == 0) { int o = 0; for (int ee = 0; ee < 32; ++ee) { OFFS[ee] = o; const int pad = (TOT[ee] + 255) & ~255; for (int t = o / 256; t < (o + pad) / 256; ++t) TILE_E[t] = ee; o += pad; } OFFS[32] = o; }
    __syncthreads();
}
__device__ __forceinline__ void phase_dispatch(const Params& p, LAS unsigned char* lds) {
    const int tid = threadIdx.x; unsigned char* ws = p.ws;
    const int* CNT = (const int*)(ws + RT_CNT); const int* ASG_E = (const int*)(ws + RT_ASG_E); const int* ASG_R = (const int*)(ws + RT_ASG_R); const float* ASG_W = (const float*)(ws + RT_ASG_W);
    int* POS = (int*)(ws + RT_POS); int* BUF_TOK = (int*)(ws + RT_BUF_TOK); float* BUF_W = (float*)(ws + RT_BUF_W);
    LAS int* OFFS = (LAS int*)lds; LAS int* TOT = OFFS + 64; LAS int* TILE_E = TOT + 64; LAS int* BASE = TILE_E + 320; LAS int* PART = BASE + 64;
    moe_tables(p, OFFS, TOT, TILE_E, PART);
    for (int tile = blockIdx.x; tile < M / 128; tile += gridDim.x) {
        __syncthreads();
        if (tid < 32) { const int qb = tile >> 4; int sb = OFFS[tid];
            for (int q = 0; q < qb; ++q) sb += PART[q * 32 + tid];
            int v[16];
#pragma unroll
            for (int j = 0; j < 16; ++j) v[j] = (16 * qb + j < tile) ? CNT[(16 * qb + j) * 32 + tid] : 0;
#pragma unroll
            for (int j = 0; j < 16; ++j) sb += v[j];
            BASE[tid] = sb; }
        __syncthreads();
        if (tid < 256) { const int a = tile * 256 + tid; const int e = ASG_E[a]; const int pos = BASE[e] + ASG_R[a]; POS[a] = pos; BUF_TOK[pos] = tile * 128 + (tid >> 1); BUF_W[pos] = ASG_W[a]; }
    }
    if (blockIdx.x < 32) { const int e = blockIdx.x; const int lo = OFFS[e] + TOT[e], hi = OFFS[e + 1]; for (int r = lo + tid; r < hi; r += NTHREADS) { BUF_TOK[r] = 0; BUF_W[r] = 0.f; } }
}
__device__ __forceinline__ void phase_moe_combine(const Params& p, LAS unsigned char* lds, int l, bool final_norm) {
    const int tid = threadIdx.x, lane = tid & 63, wave = __builtin_amdgcn_readfirstlane(tid >> 6);
    const int gw = blockIdx.x * NWAVES + wave, NGW = gridDim.x * NWAVES;
    unsigned char* ws = p.ws; bf16_t* XB = (bf16_t*)(ws + WS_XB); const bf16_t* Y = (const bf16_t*)(ws + WS_Y); const int* POS = (const int*)(ws + RT_POS);
    const float* MOD = (const float*)(ws + WS_MOD); bf16_t* HB = (bf16_t*)(ws + WS_HB);
    const int RPW = (M + NGW - 1) / NGW;
    const int rwg = blockIdx.x * NWAVES * RPW; const int b = (rwg < M ? rwg : 0) / SEQ;
    LAS float* GATE = (LAS float*)lds; LAS float* GS = GATE + 2048; LAS float* SH = GS + 2048;
    __syncthreads();
    for (int k = tid; k < 2048; k += NTHREADS) {
        GATE[k] = MOD[(size_t)(l * 9 + b) * 12288 + 5 * 2048 + k];
        if (!final_norm) { const float* md = MOD + (size_t)((l + 1) * 9 + b) * 12288; GS[k] = p.in[6][(size_t)(l + 1) * D + k] * (1.0f + md[2048 + k]); SH[k] = md[k]; }
        else { GS[k] = p.in[8][k]; SH[k] = 0.f; }
    }
    __syncthreads();
    const int r0 = gw * RPW; const int n = r0 < M ? ((M - r0) < RPW ? (M - r0) : RPW) : 0;
    u32x2 xa[8], ya0[8], ya1[8], xb[8], yb0[8], yb1[8];
#define MC_LOAD(xw, y0, y1, r_) do { const int _r = (r_) < M ? (r_) : M - 1; const int _p0 = POS[2 * _r], _p1 = POS[2 * _r + 1]; \
        const u32x2* _y0 = (const u32x2*)(Y + (size_t)_p0 * D); const u32x2* _y1 = (const u32x2*)(Y + (size_t)_p1 * D); const u32x2* _xr = (const u32x2*)(XB + (size_t)_r * D); \
        _Pragma("unroll") for (int j = 0; j < 8; ++j) { xw[j] = _xr[lane + 64 * j]; y0[j] = _y0[lane + 64 * j]; y1[j] = _y1[lane + 64 * j]; } } while (0)
#define MC_STORE(xw, y0, y1, r_) do { const int r = (r_); f32x4 v[8]; float sq = 0.f; \
        _Pragma("unroll") for (int j = 0; j < 8; ++j) { const u32x2 a = y0[j], c = y1[j]; f32x4 f; f.x = bf_lo(a.x) + bf_lo(c.x); f.y = bf_hi(a.x) + bf_hi(c.x); f.z = bf_lo(a.y) + bf_lo(c.y); f.w = bf_hi(a.y) + bf_hi(c.y); \
            const f32x4 x = (f32x4){bf_lo(xw[j].x), bf_hi(xw[j].x), bf_lo(xw[j].y), bf_hi(xw[j].y)}; v[j] = x + *(const LAS f32x4*)(GATE + 4 * (lane + 64 * j)) * f; } \
        if (!final_norm) { u32x2* xr = (u32x2*)(XB + (size_t)r * D); \
            _Pragma("unroll") for (int j = 0; j < 8; ++j) { u32x2 o; o.x = cvt_pk_bf16(v[j].x, v[j].y); o.y = cvt_pk_bf16(v[j].z, v[j].w); xr[lane + 64 * j] = o; \
                v[j] = (f32x4){bf_lo(o.x), bf_hi(o.x), bf_lo(o.y), bf_hi(o.y)}; } }     \
        _Pragma("unroll") for (int j = 0; j < 8; ++j) sq += (v[j].x * v[j].x + v[j].y * v[j].y) + (v[j].z * v[j].z + v[j].w * v[j].w); \
        sq = wave_sum(sq); const float rinv = 1.0f / sqrtf(sq * (1.0f / D) + EPS); \
        if (!final_norm) { \
            _Pragma("unroll") for (int j = 0; j < 8; ++j) { const f32x4 h = v[j] * rinv * *(const LAS f32x4*)(GS + 4 * (lane + 64 * j)) + *(const LAS f32x4*)(SH + 4 * (lane + 64 * j)); \
                u32x2 w2; w2.x = cvt_pk_bf16(h.x, h.y); w2.y = cvt_pk_bf16(h.z, h.w); ((u32x2*)(HB + (size_t)r * D))[lane + 64 * j] = w2; } \
        } else { \
            _Pragma("unroll") for (int j = 0; j < 8; ++j) ((f32x4*)(p.out + (size_t)r * D))[lane + 64 * j] = v[j] * rinv * *(const LAS f32x4*)(GS + 4 * (lane + 64 * j)); } } while (0)
    if (n > 0) {
        MC_LOAD(xa, ya0, ya1, r0);
        int k = 0;
        for (; k + 2 < n; k += 2) {
            MC_LOAD(xb, yb0, yb1, r0 + k + 1); MC_STORE(xa, ya0, ya1, r0 + k);
            MC_LOAD(xa, ya0, ya1, r0 + k + 2); MC_STORE(xb, yb0, yb1, r0 + k + 1);
        }
        MC_LOAD(xb, yb0, yb1, r0 + k + 1);
        if (k < n) MC_STORE(xa, ya0, ya1, r0 + k);
        if (k + 1 < n) MC_STORE(xb, yb0, yb1, r0 + k + 1);
    }
#undef MC_LOAD
#undef MC_STORE
}
__device__ __forceinline__ void phase_conv(const Params& p) {
    const int lane = threadIdx.x & 63, wave = __builtin_amdgcn_readfirstlane(threadIdx.x >> 6);
    const int gw = blockIdx.x * NWAVES + wave, NGW = gridDim.x * NWAVES;
    unsigned char* ws = p.ws; const bf16_t* Z = (const bf16_t*)(ws + WS_P1); const bf16_t* BG = (const bf16_t*)(ws + WS_P1 + P1_STRIDE);
    bf16_t* A2 = (bf16_t*)(ws + WS_HB); const float* cw = p.in[18];
    for (int it = gw; it < (M / 64) * 4; it += NGW) {
        const int grow = it >> 2, cb = it & 3; const int c0 = cb * 512 + lane * 8; const size_t r0 = (size_t)grow * 64;
        float w0[8], w1[8], w2[8];
#pragma unroll
        for (int j = 0; j < 8; ++j) { w0[j] = cw[c0 + j]; w1[j] = cw[2048 + c0 + j]; w2[j] = cw[4096 + c0 + j]; }
        float zp[8], zc[8];
#pragma unroll
        for (int j = 0; j < 8; ++j) zp[j] = 0.f;
        { const u32x4 z4 = *(const u32x4*)(Z + r0 * D + c0); const unsigned zw[4] = {z4.x, z4.y, z4.z, z4.w};
#pragma unroll
          for (int j = 0; j < 4; ++j) { zc[2 * j] = bf_lo(zw[j]); zc[2 * j + 1] = bf_hi(zw[j]); } }
        u32x4 zn = *(const u32x4*)(Z + (r0 + 1) * D + c0), bgc = *(const u32x4*)(BG + r0 * D + c0);
#pragma unroll 4
        for (int i = 0; i < 64; ++i) {
            const u32x4 znn = *(const u32x4*)(Z + (r0 + (i + 2 < 64 ? i + 2 : 63)) * D + c0), bgn = *(const u32x4*)(BG + (r0 + (i + 1 < 64 ? i + 1 : 63)) * D + c0);
            const unsigned zw[4] = {zn.x, zn.y, zn.z, zn.w}, bw[4] = {bgc.x, bgc.y, bgc.z, bgc.w};
            float znf[8];
#pragma unroll
            for (int j = 0; j < 4; ++j) { znf[2 * j] = (i < 63) ? bf_lo(zw[j]) : 0.f; znf[2 * j + 1] = (i < 63) ? bf_hi(zw[j]) : 0.f; }
            unsigned o[4];
#pragma unroll
            for (int j = 0; j < 4; ++j) { const float y0 = w0[2 * j] * zp[2 * j] + w1[2 * j] * zc[2 * j] + w2[2 * j] * znf[2 * j], y1 = w0[2 * j + 1] * zp[2 * j + 1] + w1[2 * j + 1] * zc[2 * j + 1] + w2[2 * j + 1] * znf[2 * j + 1];
                o[j] = cvt_pk_bf16(bf_lo(bw[j]) * y0, bf_hi(bw[j]) * y1); }
            *(u32x4*)(A2 + (r0 + i) * D + c0) = (u32x4){o[0], o[1], o[2], o[3]};
#pragma unroll
            for (int j = 0; j < 8; ++j) { zp[j] = zc[j]; zc[j] = znf[j]; }
            zn = znn; bgc = bgn;
        }
    }
}

constexpr int NPHASES = 20;
__global__ void __launch_bounds__(NTHREADS, 2) fwd_kernel(Params p) {
    extern __shared__ __attribute__((aligned(16))) unsigned char lds_raw[];
    LAS unsigned char* lds = (LAS unsigned char*)lds_raw;
    volatile LAS unsigned* MISC = (volatile LAS unsigned*)(lds + MISC_OFF);
    const int tid = threadIdx.x;
    for (int u = tid; u < (LDS_BYTES - MISC_OFF) / 4; u += NTHREADS) ((LAS unsigned*)(lds + MISC_OFF))[u] = 0u;
    __syncthreads();
    unsigned char* ws = p.ws;
    unsigned* barw = (unsigned*)(ws + WS_CTL) + CW_BAR;
    const bool multi = (p.ph_hi - p.ph_lo) > 1;
    XcdBarrier bar; bar.bar = barw; bar.x = 0; bar.st = nullptr;
    if (multi) bar = xcd_barrier_post(barw, MISC + 8);
    const int lo = p.ph_lo, hi = p.ph_hi;
#ifndef PH_MASK
#define PH_MASK 0xFFFFFu
#endif
#define IN(k) ((((PH_MASK) >> (k)) & 1u) && lo <= (k) && (k) < hi)
#define SEAM(k) do { if (IN(k) && IN((k) + 1)) xcd_barrier(bar); } while (0)
    const int G = gridDim.x, bx = blockIdx.x;
    LAS int* OFFS = (LAS int*)(lds + MISC_OFF + 64); LAS int* TOT = OFFS + 64; LAS int* TILE_E = TOT + 64;

    if (IN(0)) { phase_prologue(p, lds); } SEAM(0);
    if (IN(1)) { phase_finalize(p); } SEAM(1);
    if (IN(2)) { phase_norm_mix0(p); } SEAM(2);
    if (IN(3)) {
        pg8::Gemm g{(const bf16_t*)(ws + WS_HB), (const bf16_t*)(ws + WS_WIN0), D, nullptr};
        InProj0Order S; S.so.init(M, 7168, G, bx);
        EpiInProj0 E{ws, (const float*)(ws + WS_LB)};
        pg8::gemm_phase<EpiInProj0, InProj0Order, false>(lds, g, S, E);
    } SEAM(3);
    if (IN(4)) {
        for (int c = bx; c < 256; c += G) { __syncthreads(); phase_scan(p, lds, G == 256 ? (c & 7) * 32 + (c >> 3) : c); }
    } SEAM(4);
    if (IN(5)) {
        for (int u = bx; u < 256; u += G) phase_gmlp(p, lds, u);
        phase_hgrn_out(p);
    } SEAM(5);
    if (IN(6)) {
        pg8::Gemm g{(const bf16_t*)(ws + WS_HB), (const bf16_t*)(ws + WS_WOUT0), D, nullptr};
        pg8::StaticOrder S; S.init(M, D, G, bx);
        EpiResid<true> E{p.in[0], (bf16_t*)(ws + WS_XB), (const float*)(ws + WS_MOD) + 2 * 2048};
        pg8::gemm_phase<EpiResid<true>, pg8::StaticOrder, false>(lds, g, S, E);
    } SEAM(6);
#define MOE_BLOCK(l, pb) do { \
        if (IN(pb)) { phase_router(p, lds, l); } SEAM(pb); \
        if (IN((pb) + 1)) { phase_dispatch(p, lds); } SEAM((pb) + 1); \
        if (IN((pb) + 2)) { \
            __syncthreads(); moe_tables(p, OFFS, TOT, TILE_E, (LAS int*)lds); \
            pg8::Gemm g{(const bf16_t*)(ws + WS_HB), (const bf16_t*)(ws + WS_EGU) + (size_t)(l) * 32 * 1024 * 2048, D, (const int*)(ws + RT_BUF_TOK)}; \
            MoeOrder S{G, bx, 4, (OFFS[32] / 256) * 4, TILE_E}; \
            EpiGateUp E{(bf16_t*)(ws + WS_HMID)}; \
            pg8::gemm_phase<EpiGateUp, MoeOrder, true>(lds, g, S, E); \
        } SEAM((pb) + 2); \
        if (IN((pb) + 3)) { \
            __syncthreads(); moe_tables(p, OFFS, TOT, TILE_E, (LAS int*)lds); \
            pg8::Gemm g{(const bf16_t*)(ws + WS_HMID), (const bf16_t*)(ws + WS_EDN) + (size_t)(l) * 32 * 2048 * 512, EFF, nullptr}; \
            MoeOrder S{G, bx, 8, (OFFS[32] / 256) * 8, TILE_E}; \
            EpiDown E{(bf16_t*)(ws + WS_Y), (const float*)(ws + RT_BUF_W)}; \
            pg8::gemm_phase<EpiDown, MoeOrder, false>(lds, g, S, E); \
        } SEAM((pb) + 3); \
        if (IN((pb) + 4)) { phase_moe_combine(p, lds, l, (l) == 1); } SEAM((pb) + 4); \
    } while (0)
    MOE_BLOCK(0, 7);
    if (IN(12)) {
        pg8::Gemm g{(const bf16_t*)(ws + WS_HB), (const bf16_t*)(ws + WS_WIN1), D, nullptr};
        pg8::StaticOrder S; S.init(M, 6144, G, bx);
        EpiOddIn E{(bf16_t*)(ws + WS_P1), (bf16_t*)(ws + WS_P1 + P1_STRIDE)};
        pg8::gemm_phase<EpiOddIn, pg8::StaticOrder, false>(lds, g, S, E);
    } SEAM(12);
    if (IN(13)) { phase_conv(p); } SEAM(13);
    if (IN(14)) {
        pg8::Gemm g{(const bf16_t*)(ws + WS_HB), (const bf16_t*)(ws + WS_WOUT1), D, nullptr};
        pg8::StaticOrder S; S.init(M, D, G, bx);
        EpiResid<false> E{ws + WS_XB, (bf16_t*)(ws + WS_XB), (const float*)(ws + WS_MOD) + 9 * 12288 + 2 * 2048};
        pg8::gemm_phase<EpiResid<false>, pg8::StaticOrder, false>(lds, g, S, E);
    } SEAM(14);
    MOE_BLOCK(1, 15);
#undef MOE_BLOCK
#undef IN
#undef SEAM
}

extern "C" void kernel_launch(void* const* d_in, const int* in_sizes, int n_in, void* d_out, int out_size, void* d_ws, size_t ws_size, hipStream_t stream) {
    static int grid = 0;
    if (grid == 0) {
        if (n_in != 27 || out_size != M * D || ws_size < WS_END) { fprintf(stderr, "kernel_launch: unexpected shapes: n_in %d out %d ws %zu (need %zu)\n", n_in, out_size, ws_size, (size_t)WS_END); grid = -1; return; }
        int dev = 0, cus = 0, per_cu = 0;
        if (hipGetDevice(&dev) != hipSuccess || hipDeviceGetAttribute(&cus, hipDeviceAttributeMultiprocessorCount, dev) != hipSuccess) { grid = -1; return; }
        if (hipFuncSetAttribute((const void*)fwd_kernel, hipFuncAttributeMaxDynamicSharedMemorySize, LDS_BYTES) != hipSuccess) { fprintf(stderr, "kernel_launch: hipFuncSetAttribute failed\n"); grid = -1; return; }
        if (hipOccupancyMaxActiveBlocksPerMultiprocessor(&per_cu, (const void*)fwd_kernel, NTHREADS, LDS_BYTES) != hipSuccess || per_cu < 1)
            fprintf(stderr, "kernel_launch: occupancy query reports %d workgroups per CU\n", per_cu);
        (void)hipGetLastError();
        grid = cus;
    }
    if (grid < 0) return;
    (void)hipMemsetAsync((char*)d_ws + WS_CTL, 0, CTL_ZERO_BYTES, stream);
    Params p{};
    for (int i = 0; i < 27; ++i) p.in[i] = (const float*)d_in[i];
    p.out = (float*)d_out; p.ws = (unsigned char*)d_ws;
#if MK_ONE_LAUNCH
    p.ph_lo = 0; p.ph_hi = NPHASES;
    hipLaunchKernelGGL(fwd_kernel, dim3(grid), dim3(NTHREADS), LDS_BYTES, stream, p);
#else
#ifndef MAX_PHASE
#define MAX_PHASE NPHASES
#endif
    for (int ph = 0; ph < MAX_PHASE; ++ph) { p.ph_lo = ph; p.ph_hi = ph + 1; hipLaunchKernelGGL(fwd_kernel, dim3(grid), dim3(NTHREADS), LDS_BYTES, stream, p); }
#endif
}
```

```cpp
#include <hip/hip_runtime.h>
#include <cstdio>
#include <cstdint>

#define LAS __attribute__((address_space(3)))
#define GAS __attribute__((address_space(1)))
typedef unsigned short bf16_t;
typedef short bf16x8 __attribute__((ext_vector_type(8)));
typedef float f32x4 __attribute__((ext_vector_type(4)));
typedef float f32x2 __attribute__((ext_vector_type(2)));
typedef unsigned u32x4 __attribute__((ext_vector_type(4)));
typedef unsigned u32x2 __attribute__((ext_vector_type(2)));

#ifndef MK_ONE_LAUNCH
#define MK_ONE_LAUNCH 1
#endif

constexpr int D = 2048, NB = 8, SEQ = 4096, M = NB * SEQ, CL = 256, MC = NB * CL;
constexpr int WA = 1024, NE = 32, EFF = 512;
constexpr int NASG = 2 * M, MAXROWS = NASG + NE * 256, MAXTILES = MAXROWS / 256;
constexpr float EPS = 1e-6f;
constexpr int NWAVES = 8, NTHREADS = 512;

constexpr size_t MiB = 1u << 20;
constexpr size_t WS_CTL = 0, CTL_ZERO_BYTES = 1 * MiB;
constexpr size_t WS_MOD = 1 * MiB;
constexpr size_t WS_LB = 2 * MiB;
constexpr size_t WS_RW = 3 * MiB;
constexpr size_t WS_RB = 4 * MiB;
constexpr size_t WS_MP = 8 * MiB;
constexpr size_t WS_WIN0 = 22 * MiB, WS_WOUT0 = 50 * MiB, WS_WIN1 = 58 * MiB, WS_WOUT1 = 82 * MiB, WS_EGU = 90 * MiB, WS_EDN = 346 * MiB;
constexpr size_t WS_HB = 474 * MiB;
constexpr size_t WS_R = 610 * MiB;
constexpr size_t WS_Q = WS_R, PROJ_STRIDE = 64 * MiB;
constexpr size_t WS_CTXP = WS_R + 7 * 64 * MiB, CTXP_STRIDE = 4 * MiB;
constexpr size_t WS_OF = WS_CTXP + 12 * MiB, WS_OB = WS_OF + 64 * MiB;
constexpr size_t WS_Y = WS_R, WS_HMID = WS_R + 288 * MiB;
constexpr size_t WS_P1 = WS_R, P1_STRIDE = 128 * MiB;
constexpr size_t WS_RT = 1198 * MiB;
constexpr size_t RT_ASG_E = WS_RT, RT_ASG_R = RT_ASG_E + 262144, RT_ASG_W = RT_ASG_R + 262144, RT_POS = RT_ASG_W + 262144,
                 RT_BUF_TOK = RT_POS + 262144, RT_BUF_W = RT_BUF_TOK + 294912, RT_CNT = RT_BUF_W + 294912;
constexpr size_t WS_XB = 1201 * MiB;
constexpr size_t WS_END = 1329 * MiB;
static_assert(WS_OB + 64 * MiB <= WS_RT && RT_CNT + 32768 <= WS_XB && WS_HMID + 72 * MiB <= WS_RT && WS_P1 + 3 * P1_STRIDE <= WS_RT, "ws map");
constexpr int CW_BAR = 4096;

constexpr int RING_BYTES = 131072;
constexpr int MISC_OFF = 147456;
constexpr int LDS_BYTES = 163840;

typedef __bf16 bf16x2_t __attribute__((ext_vector_type(2)));
__device__ __forceinline__ unsigned cvt_pk_bf16(float lo, float hi) { const f32x2 v = {lo, hi}; return __builtin_bit_cast(unsigned, __builtin_convertvector(v, bf16x2_t)); }
__device__ __forceinline__ float bf_lo(unsigned w) { return __uint_as_float(w << 16); }
__device__ __forceinline__ float bf_hi(unsigned w) { return __uint_as_float(w & 0xffff0000u); }
__device__ __forceinline__ float bf2f(bf16_t b) { return __uint_as_float(((unsigned)b) << 16); }
__device__ __forceinline__ float wave_sum(float v) {
#pragma unroll
    for (int o = 1; o < 64; o <<= 1) v += __shfl_xor(v, o);
    return v;
}
__device__ __forceinline__ float fast_sigmoid(float x) { return __builtin_amdgcn_rcpf(1.0f + __expf(-x)); }
__device__ __forceinline__ float silu_f(float x) { return x * fast_sigmoid(x); }
__device__ __forceinline__ float gelu_tanh_f(float x) { const float u = 0.7978845608028654f * (x + 0.044715f * x * x * x); return x * fast_sigmoid(2.0f * u); }
#define LDS_WAIT() asm volatile("s_waitcnt lgkmcnt(0)" ::: "memory")
#define VM_WAIT() asm volatile("s_waitcnt vmcnt(0)" ::: "memory")
#define LDS_BARRIER() do { asm volatile("s_waitcnt lgkmcnt(0)" ::: "memory"); __builtin_amdgcn_s_barrier(); asm volatile("" ::: "memory"); } while (0)

#define XB_TMO      128
#define XB_XCNT(j)  (256  + 64 * (j))
#define XB_XSUB(j)  (1280 + 64 * (j))
#define XB_XGEN(j)  (2304 + 64 * (j))
#define XB_TOP      3328
#define XB_TOPGEN   3392
#define XCD_BAR_WORDS 3456
#define XB_SPIN_CAP (1u << 22)
__device__ __forceinline__ unsigned xb_ld(unsigned* p)              { return __hip_atomic_load(p, __ATOMIC_RELAXED, __HIP_MEMORY_SCOPE_AGENT); }
__device__ __forceinline__ unsigned xb_add(unsigned* p, unsigned v) { return __hip_atomic_fetch_add(p, v, __ATOMIC_RELAXED, __HIP_MEMORY_SCOPE_AGENT); }
__device__ __forceinline__ unsigned xb_xcc_id() { return (unsigned)__builtin_amdgcn_s_getreg((3 << 11) | 20) & 0xFu; }
#define XB_SPIN(cond, bar) do { unsigned _sp = 0; while (cond) { __builtin_amdgcn_s_sleep(1); \
    if ((++_sp & 255u) == 0u) { if (xb_ld(&(bar)[XB_TMO])) break; if (_sp > XB_SPIN_CAP) { atomicAdd(&(bar)[XB_TMO], 1u); break; } } } } while (0)
struct XcdBarrier { unsigned* bar; unsigned x; volatile LAS unsigned* st; };
__device__ __forceinline__ XcdBarrier xcd_barrier_post(unsigned* bar, volatile LAS unsigned* st) {
    XcdBarrier b; b.bar = bar; b.x = xb_xcc_id(); b.st = st;
    if (threadIdx.x == 0) (void)xb_add(&bar[XB_XCNT(b.x)], 1u);
    return b;
}
__device__ __forceinline__ void xcd_barrier_complete(unsigned* bar, unsigned x, unsigned& nloc, unsigned& nx) {
    const unsigned G = gridDim.x * gridDim.y * gridDim.z;
    unsigned sum, cnt, mine, sp = 0u;
    for (;;) {
        sum = 0u; cnt = 0u; mine = 0u;
#pragma unroll
        for (unsigned j = 0; j < 16; ++j) { const unsigned c = xb_ld(&bar[XB_XCNT(j)]); sum += c; cnt += (c > 0u) ? 1u : 0u; mine = (j == x) ? c : mine; }
        if (sum == G) break;
        __builtin_amdgcn_s_sleep(1);
        if ((++sp & 255u) == 0u) { if (xb_ld(&bar[XB_TMO])) break; if (sp > XB_SPIN_CAP) { atomicAdd(&bar[XB_TMO], 1u); break; } }
    }
    nloc = mine > 0u ? mine : 1u; nx = cnt > 0u ? cnt : 1u;
}
__device__ __forceinline__ void xcd_barrier(const XcdBarrier& b) {
    asm volatile("s_waitcnt vmcnt(0)" ::: "memory");
    __syncthreads();
    if (threadIdx.x == 0) {
        unsigned* bar = b.bar;
        __builtin_amdgcn_s_waitcnt(0);
        unsigned nloc = b.st[0], nx = b.st[1];
        if (nloc == 0u) { xcd_barrier_complete(bar, b.x, nloc, nx); b.st[0] = nloc; b.st[1] = nx; }
        const unsigned old = xb_add(&bar[XB_XSUB(b.x)], 1u);
        const unsigned gen = old / nloc;
        if (old + 1u == (gen + 1u) * nloc) {
            __builtin_amdgcn_fence(__ATOMIC_RELEASE, "agent");
            asm volatile("s_waitcnt vmcnt(0)" ::: "memory");
            const unsigned og = xb_add(&bar[XB_TOP], 1u);
            const unsigned tg = og / nx;
            if (og + 1u == (tg + 1u) * nx) xb_add(&bar[XB_TOPGEN], 1u);
            else XB_SPIN(xb_ld(&bar[XB_TOPGEN]) == tg, bar);
            __builtin_amdgcn_fence(__ATOMIC_ACQUIRE, "agent");
            xb_add(&bar[XB_XGEN(b.x)], 1u);
            asm volatile("s_waitcnt vmcnt(0)" ::: "memory");
        } else {
            XB_SPIN(xb_ld(&bar[XB_XGEN(b.x)]) == gen, bar);
            __builtin_amdgcn_fence(__ATOMIC_ACQUIRE, "agent");
            asm volatile("s_waitcnt vmcnt(0)" ::: "memory");
        }
    }
    __syncthreads();
}

namespace pg8 {
constexpr int BM = 256, BK = 64, HALF = 128, HTB = HALF * BK * 2, STAGE_BYTES = 8 * HTB, NXCD = 8, WGM = 4;
__host__ __device__ __forceinline__ int lds_byte(int r, int c) { const int st = (r >> 4) * 2 + (c >> 5), rr = r & 15, cc = c & 31, ob = rr * 64 + cc * 2; return st * 1024 + (ob ^ (((ob >> 9) & 1) << 5)); }
__host__ __device__ __forceinline__ void stage_rc(int b, int& R, int& C) { const int st = b / 1024, sb = b % 1024, swz = sb ^ (((sb >> 9) & 1) << 5); R = (st >> 1) * 16 + swz / 64; C = (st & 1) * 32 + (swz % 64) / 2; }
__host__ __device__ __forceinline__ int perm32(int rho) { const int n = rho >> 4, i = rho & 15; return 8 * (i >> 2) + 4 * n + (i & 3); }
struct Unit { int pm, pn, pb; };
struct Gemm { const bf16_t* A; const bf16_t* Bt; int K; const int* rowtab; };
struct StaticOrder {
    int nM, nN, nwg, G, c;
    __device__ void init(int Mr, int N, int G_, int c_) { nM = Mr / BM; nN = N / BM; nwg = nM * nN; G = G_; c = c_; }
    __device__ __forceinline__ bool map(long Lu, Unit& u) const {
        if (Lu >= nwg) return false;
        int wgid = (int)Lu; { const int q = nwg / NXCD, r = nwg % NXCD, xcd = wgid % NXCD, off = wgid / NXCD; wgid = (xcd < r ? xcd * (q + 1) : r * (q + 1) + (xcd - r) * q) + off; }
        const int nig = WGM * nN, gid = wgid / nig, fm = gid * WGM, gsz = (nM - fm) < WGM ? (nM - fm) : WGM;
        u.pm = fm + ((wgid % nig) % gsz); u.pn = (wgid % nig) / gsz; u.pb = u.pn; return true;
    }
    __device__ __forceinline__ bool next(int i, Unit& u) const { return map((long)i * G + c, u); }
};

template <class Epi, class Sched, bool GATHER>
__device__ __forceinline__ void gemm_phase(LAS unsigned char* lds, const Gemm g, const Sched& S, const Epi& E) {
    const int tid = threadIdx.x, wid = __builtin_amdgcn_readfirstlane(tid >> 6), lane = tid & 63, wr = wid >> 2, wc = wid & 3, fr = lane & 15, fq = lane >> 4;
    const int K = g.K, nt = K / BK;
    unsigned voffB[2]; int rA[2]; unsigned cA2[2];
#pragma unroll
    for (int i = 0; i < 2; ++i) { int R, C; stage_rc(tid * 16 + i * 8192, R, C); const int Rb = Epi::COLMAP64 ? (64 * (R >> 5) + perm32(R & 31)) : (Epi::PERM ? ((R & ~31) + perm32(R & 31)) : R);
        rA[i] = R; cA2[i] = (unsigned)C * 2u; voffB[i] = (unsigned)(Rb * K + C) * 2u; }
    const size_t kstep = (size_t)(BK * 2);
    const size_t hstep = (size_t)(Epi::COLMAP64 ? 32 : HALF) * K * 2;
    const size_t tstep = (size_t)BM * K * 2;
    const unsigned ldsw = (unsigned)wid * 1024u;
    const int aoff = lds_byte(wr * 64 + fr, fq * 8), boff = lds_byte(wc * 32 + fr, fq * 8);
    const unsigned rowbytes = (unsigned)K * 2u;
#define PG8_SA(b, h) (((b) * 2 + (h)) * HTB)
#define PG8_SB(b, h) ((4 + (b) * 2 + (h)) * HTB)
#define PG8_STAGE(bufoff, gbase, voff) do { _Pragma("unroll") for (int _i = 0; _i < 2; ++_i) \
        __builtin_amdgcn_global_load_lds((const unsigned*)((const char*)(gbase) + (voff)[_i]), (LAS unsigned*)(lds + (bufoff) + ldsw + _i * 8192), 16, 0, 0); } while (0)
#define PG8_STAGE2(bufoff, gbase, o0, o1) do { \
        __builtin_amdgcn_global_load_lds((const unsigned*)((const char*)(gbase) + (o0)), (LAS unsigned*)(lds + (bufoff) + ldsw), 16, 0, 0); \
        __builtin_amdgcn_global_load_lds((const unsigned*)((const char*)(gbase) + (o1)), (LAS unsigned*)(lds + (bufoff) + ldsw + 8192), 16, 0, 0); } while (0)
#define PG8_LDA(dst, b, h) do { _Pragma("unroll") for (int m = 0; m < 4; ++m) _Pragma("unroll") for (int k = 0; k < 2; ++k) dst[m][k] = *(const LAS bf16x8*)(lds + PG8_SA(b, h) + aoff + m * 2048 + k * 1024); } while (0)
#define PG8_LDB(dst, b, h) do { _Pragma("unroll") for (int n = 0; n < 2; ++n) _Pragma("unroll") for (int k = 0; k < 2; ++k) dst[n][k] = *(const LAS bf16x8*)(lds + PG8_SB(b, h) + boff + n * 2048 + k * 1024); } while (0)
#define PG8_MMA(ai, bj, At, Bt) do { __builtin_amdgcn_s_setprio(1); _Pragma("unroll") for (int m = 0; m < 4; ++m) _Pragma("unroll") for (int n = 0; n < 2; ++n) _Pragma("unroll") for (int k = 0; k < 2; ++k) \
        acc[ai][bj][m][n] = __builtin_amdgcn_mfma_f32_16x16x32_bf16(Bt[n][k], At[m][k], acc[ai][bj][m][n], 0, 0, 0); __builtin_amdgcn_s_setprio(0); } while (0)
#define PG8_WAIT_V(n) asm volatile("s_waitcnt vmcnt(" #n ")" ::: "memory")
#define PG8_WAIT_L(n) asm volatile("s_waitcnt lgkmcnt(" #n ")" ::: "memory")
#define PG8_BAR __builtin_amdgcn_s_barrier()
#define PG8_SCHED __builtin_amdgcn_sched_barrier(0)
#define PG8_AOFF(dst, u) do { _Pragma("unroll") for (int _h = 0; _h < 2; ++_h) _Pragma("unroll") for (int _i = 0; _i < 2; ++_i) { \
        const int _r = (u).pm * BM + _h * HALF + rA[_i]; const unsigned _row = GATHER ? (unsigned)g.rowtab[_r] : (unsigned)_r; dst[_h][_i] = _row * rowbytes + cA2[_i]; } } while (0)
    Unit cur, nxt; int ui = 0;
    if (!S.next(0, cur)) return;
    f32x4 acc[2][2][4][2];
#pragma unroll
    for (int a = 0; a < 2; ++a)
#pragma unroll
        for (int b = 0; b < 2; ++b)
#pragma unroll
            for (int m = 0; m < 4; ++m)
#pragma unroll
                for (int n = 0; n < 2; ++n) acc[a][b][m][n] = (f32x4){0.f, 0.f, 0.f, 0.f};
    bf16x8 At[4][2], B0[2][2], B1[2][2];
    unsigned ga[2][2], gn[2][2];
    PG8_AOFF(ga, cur);
    const char* const A0 = (const char*)g.A;
    const char* cB = (const char*)g.Bt + (size_t)cur.pb * tstep;
    PG8_STAGE(PG8_SB(0, 0), cB, voffB); PG8_STAGE2(PG8_SA(0, 0), A0, ga[0][0], ga[0][1]); PG8_STAGE(PG8_SB(0, 1), cB + hstep, voffB); PG8_STAGE2(PG8_SA(0, 1), A0, ga[1][0], ga[1][1]);
    if (wr == 1) PG8_BAR;
    PG8_WAIT_V(4); PG8_BAR;
    PG8_STAGE(PG8_SB(1, 0), cB + kstep, voffB); PG8_STAGE2(PG8_SA(1, 0), A0 + kstep, ga[0][0], ga[0][1]); PG8_STAGE(PG8_SB(1, 1), cB + hstep + kstep, voffB);
    PG8_WAIT_V(6); PG8_BAR;
    for (;;) {
        const bool has_next = S.next(ui + 1, nxt);
        if (has_next) { PG8_AOFF(gn, nxt); } else {
#pragma unroll
            for (int h = 0; h < 2; ++h)
#pragma unroll
                for (int i = 0; i < 2; ++i) gn[h][i] = ga[h][i]; }
        const char* nB = has_next ? (const char*)g.Bt + (size_t)nxt.pb * tstep : cB;
        for (int t = 0; t < nt; t += 2) {
            const bool last = (t == nt - 2);
            const char* a1 = A0 + (size_t)(t + 1) * kstep;
            const char* a2 = last ? A0 : A0 + (size_t)(t + 2) * kstep; const char* b2 = last ? nB : cB + (size_t)(t + 2) * kstep;
            const char* a3 = a2 + kstep; const char* b3 = b2 + kstep;
            const unsigned o00 = last ? gn[0][0] : ga[0][0], o01 = last ? gn[0][1] : ga[0][1], o10 = last ? gn[1][0] : ga[1][0], o11 = last ? gn[1][1] : ga[1][1];
            PG8_LDB(B0, 0, 0); PG8_SCHED; PG8_LDA(At, 0, 0); PG8_STAGE2(PG8_SA(1, 1), a1, ga[1][0], ga[1][1]);
            PG8_WAIT_L(8); PG8_BAR; PG8_WAIT_L(0); PG8_MMA(0, 0, At, B0); PG8_BAR; PG8_SCHED;
            PG8_LDB(B1, 0, 1); PG8_STAGE(PG8_SB(0, 0), b2, voffB);
            PG8_BAR; PG8_WAIT_L(0); PG8_MMA(0, 1, At, B1); PG8_BAR;
            PG8_LDA(At, 0, 1); PG8_STAGE2(PG8_SA(0, 0), a2, o00, o01);
            PG8_BAR; PG8_WAIT_L(0); PG8_MMA(1, 0, At, B0); PG8_BAR; PG8_SCHED;
            PG8_STAGE(PG8_SB(0, 1), b2 + hstep, voffB);
            PG8_WAIT_V(6); PG8_BAR; PG8_MMA(1, 1, At, B1); PG8_BAR;
            PG8_LDB(B0, 1, 0); PG8_SCHED; PG8_LDA(At, 1, 0); PG8_STAGE2(PG8_SA(0, 1), a2, o10, o11);
            PG8_WAIT_L(8); PG8_BAR; PG8_WAIT_L(0); PG8_MMA(0, 0, At, B0); PG8_BAR; PG8_SCHED;
            PG8_LDB(B1, 1, 1); PG8_STAGE(PG8_SB(1, 0), b3, voffB);
            PG8_BAR; PG8_WAIT_L(0); PG8_MMA(0, 1, At, B1); PG8_BAR;
            PG8_LDA(At, 1, 1); PG8_STAGE2(PG8_SA(1, 0), a3, o00, o01);
            PG8_BAR; PG8_WAIT_L(0); PG8_MMA(1, 0, At, B0); PG8_BAR; PG8_SCHED;
            PG8_STAGE(PG8_SB(1, 1), b3 + hstep, voffB);
            PG8_WAIT_V(6); PG8_BAR; PG8_MMA(1, 1, At, B1); PG8_BAR;
        }
        E(acc, cur, wr, wc, fr, fq);
        if (!has_next) break;
#pragma unroll
        for (int a = 0; a < 2; ++a)
#pragma unroll
            for (int b = 0; b < 2; ++b)
#pragma unroll
                for (int m = 0; m < 4; ++m)
#pragma unroll
                    for (int n = 0; n < 2; ++n) acc[a][b][m][n] = (f32x4){0.f, 0.f, 0.f, 0.f};
        cur = nxt; cB = nB; ++ui;
#pragma unroll
        for (int h = 0; h < 2; ++h)
#pragma unroll
            for (int i = 0; i < 2; ++i) ga[h][i] = gn[h][i];
    }
    PG8_WAIT_V(0);
    if (wr == 0) PG8_BAR;
    PG8_BAR;
#undef PG8_SA
#undef PG8_SB
#undef PG8_STAGE
#undef PG8_STAGE2
#undef PG8_LDA
#undef PG8_LDB
#undef PG8_MMA
#undef PG8_WAIT_V
#undef PG8_WAIT_L
#undef PG8_BAR
#undef PG8_SCHED
#undef PG8_AOFF
}
}

struct Params {
    const float* in[27];
    float* out;
    unsigned char* ws;
    int ph_lo, ph_hi;
};

struct EpiInProj0 {
    static constexpr bool PERM = true, COLMAP64 = false;
    unsigned char* ws; const float* lb;
    __device__ __forceinline__ void operator()(const f32x4 (&acc)[2][2][4][2], const pg8::Unit& u, int wr, int wc, int fr, int fq) const {
        const int t = u.pn >> 2;
        const bool ctx = u.pm >= M / 256;
        bf16_t* base = ctx ? (bf16_t*)(ws + WS_CTXP + (size_t)(t - 1) * CTXP_STRIDE) : (bf16_t*)(ws + WS_Q + (size_t)t * PROJ_STRIDE);
        const int row0 = (ctx ? u.pm * 256 - M : u.pm * 256) + wr * 64 + fr;
        const int col0 = (u.pn & 3) * 256 + wc * 32 + 8 * fq;
        const bool headmajor = t < 4;
        const int Ls = ctx ? CL : SEQ;
        f32x4 lbv[2][2];
        if (t == 1 || t == 2) {
#pragma unroll
            for (int bj = 0; bj < 2; ++bj)
#pragma unroll
                for (int n = 0; n < 2; ++n) lbv[bj][n] = *(const f32x4*)(lb + (t - 1) * 1024 + col0 + bj * 128 + 4 * n);
        }
#pragma unroll
        for (int ai = 0; ai < 2; ++ai)
#pragma unroll
            for (int m = 0; m < 4; ++m) { const int rr = row0 + ai * 128 + m * 16; const int bb = rr / Ls, pos = rr - bb * Ls;
#pragma unroll
                for (int bj = 0; bj < 2; ++bj) { f32x4 v0 = acc[ai][bj][m][0], v1 = acc[ai][bj][m][1]; u32x4 w;
                    bf16_t* dstp = headmajor ? base + ((size_t)(bb * 8 + (u.pn & 3) * 2 + bj) * Ls + pos) * 128 + wc * 32 + 8 * fq : base + (size_t)rr * 1024 + col0 + bj * 128;
                    if (t == 1 || t == 2) {
                        _Float16 hv[8];
#pragma unroll
                        for (int j = 0; j < 4; ++j) { const float l0 = lbv[bj][0][j], l1 = lbv[bj][1][j];
                            const float f0 = l0 + (1.0f - l0) * fast_sigmoid(v0[j]), f1 = l1 + (1.0f - l1) * fast_sigmoid(v1[j]);
                            hv[j] = (_Float16)f0; hv[4 + j] = (_Float16)f1; }
                        w.x = (unsigned)__builtin_bit_cast(unsigned short, hv[0]) | ((unsigned)__builtin_bit_cast(unsigned short, hv[1]) << 16);
                        w.y = (unsigned)__builtin_bit_cast(unsigned short, hv[2]) | ((unsigned)__builtin_bit_cast(unsigned short, hv[3]) << 16);
                        w.z = (unsigned)__builtin_bit_cast(unsigned short, hv[4]) | ((unsigned)__builtin_bit_cast(unsigned short, hv[5]) << 16);
                        w.w = (unsigned)__builtin_bit_cast(unsigned short, hv[6]) | ((unsigned)__builtin_bit_cast(unsigned short, hv[7]) << 16);
                    } else {
                        if (t == 0 || t == 4) {
#pragma unroll
                            for (int j = 0; j < 4; ++j) { v0[j] = silu_f(v0[j]); v1[j] = silu_f(v1[j]); }
                        } else if (t >= 5) {
#pragma unroll
                            for (int j = 0; j < 4; ++j) { v0[j] = gelu_tanh_f(v0[j]); v1[j] = gelu_tanh_f(v1[j]); }
                        }
                        w.x = cvt_pk_bf16(v0[0], v0[1]); w.y = cvt_pk_bf16(v0[2], v0[3]); w.z = cvt_pk_bf16(v1[0], v1[1]); w.w = cvt_pk_bf16(v1[2], v1[3]);
                    }
                    *(u32x4*)dstp = w; } }
    }
};
struct InProj0Order {
    pg8::StaticOrder so;
    __device__ __forceinline__ bool next(int i, pg8::Unit& u) const {
        const long Lu = (long)i * so.G + so.c;
        if (Lu < so.nwg) return so.map(Lu, u);
        const int r = (int)(Lu - so.nwg); if (r >= 96) return false;
        u.pm = M / 256 + r / 12; u.pn = 4 + r % 12; u.pb = u.pn; return true;
    }
};
struct EpiOddIn {
    static constexpr bool PERM = true, COLMAP64 = false;
    bf16_t* Z; bf16_t* BG;
    __device__ __forceinline__ void operator()(const f32x4 (&acc)[2][2][4][2], const pg8::Unit& u, int wr, int wc, int fr, int fq) const {
        const int row0 = u.pm * 256 + wr * 64 + fr;
        if (u.pn < 16) {
            const int col0 = u.pn * 128 + wc * 32 + 8 * fq;
#pragma unroll
            for (int ai = 0; ai < 2; ++ai)
#pragma unroll
                for (int m = 0; m < 4; ++m) { const f32x4 v0 = acc[ai][0][m][0] * acc[ai][1][m][0], v1 = acc[ai][0][m][1] * acc[ai][1][m][1]; u32x4 w;
                    w.x = cvt_pk_bf16(v0[0], v0[1]); w.y = cvt_pk_bf16(v0[2], v0[3]); w.z = cvt_pk_bf16(v1[0], v1[1]); w.w = cvt_pk_bf16(v1[2], v1[3]);
                    *(u32x4*)(Z + (size_t)(row0 + ai * 128 + m * 16) * 2048 + col0) = w; }
        } else {
            const int col0 = (u.pn - 16) * 256 + wc * 32 + 8 * fq;
#pragma unroll
            for (int ai = 0; ai < 2; ++ai)
#pragma unroll
                for (int m = 0; m < 4; ++m) { bf16_t* rowp = BG + (size_t)(row0 + ai * 128 + m * 16) * 2048 + col0;
#pragma unroll
                    for (int bj = 0; bj < 2; ++bj) { const f32x4 v0 = acc[ai][bj][m][0], v1 = acc[ai][bj][m][1]; u32x4 w;
                        w.x = cvt_pk_bf16(v0[0], v0[1]); w.y = cvt_pk_bf16(v0[2], v0[3]); w.z = cvt_pk_bf16(v1[0], v1[1]); w.w = cvt_pk_bf16(v1[2], v1[3]);
                        *(u32x4*)(rowp + bj * 128) = w; } }
        }
    }
};
template <bool IN_F32> struct EpiResid {
    static constexpr bool PERM = true, COLMAP64 = false;
    const void* xin; bf16_t* xout; const float* gate;
    __device__ __forceinline__ void operator()(const f32x4 (&acc)[2][2][4][2], const pg8::Unit& u, int wr, int wc, int fr, int fq) const {
        const int row0 = u.pm * 256 + wr * 64 + fr, col0 = u.pn * 256 + wc * 32 + 8 * fq;
        const int b = (u.pm * 256) / SEQ;
        unsigned yp[2][4][2][4];
#pragma unroll
        for (int bj = 0; bj < 2; ++bj)
#pragma unroll
            for (int n = 0; n < 2; ++n) { const f32x4 gv = *(const f32x4*)(gate + (size_t)b * 12288 + col0 + bj * 128 + n * 4);
#pragma unroll
                for (int ai = 0; ai < 2; ++ai)
#pragma unroll
                    for (int m = 0; m < 4; ++m) { const f32x4 y = gv * acc[ai][bj][m][n]; yp[ai][m][bj][2 * n] = cvt_pk_bf16(y.x, y.y); yp[ai][m][bj][2 * n + 1] = cvt_pk_bf16(y.z, y.w); } }
        asm volatile("" ::: "memory");
        if (IN_F32) {
#pragma unroll
            for (int ai = 0; ai < 2; ++ai) {
                f32x4 xi[4][2][2];
#pragma unroll
                for (int m = 0; m < 4; ++m) { const float* xp = (const float*)xin + (size_t)(row0 + ai * 128 + m * 16) * D + col0;
#pragma unroll
                    for (int bj = 0; bj < 2; ++bj) { xi[m][bj][0] = *(const f32x4*)(xp + bj * 128); xi[m][bj][1] = *(const f32x4*)(xp + bj * 128 + 4); } }
                asm volatile("" ::: "memory");
#pragma unroll
                for (int m = 0; m < 4; ++m) { bf16_t* op = xout + (size_t)(row0 + ai * 128 + m * 16) * D + col0;
#pragma unroll
                    for (int bj = 0; bj < 2; ++bj) { const unsigned* y = yp[ai][m][bj]; const f32x4 x0 = xi[m][bj][0], x1 = xi[m][bj][1];
                        u32x4 w; w.x = cvt_pk_bf16(x0.x + bf_lo(y[0]), x0.y + bf_hi(y[0])); w.y = cvt_pk_bf16(x0.z + bf_lo(y[1]), x0.w + bf_hi(y[1]));
                        w.z = cvt_pk_bf16(x1.x + bf_lo(y[2]), x1.y + bf_hi(y[2])); w.w = cvt_pk_bf16(x1.z + bf_lo(y[3]), x1.w + bf_hi(y[3]));
                        *(u32x4*)(op + bj * 128) = w; } }
                asm volatile("" ::: "memory");
            }
        } else {
            u32x4 xi[2][4][2];
#pragma unroll
            for (int ai = 0; ai < 2; ++ai)
#pragma unroll
                for (int m = 0; m < 4; ++m) { const bf16_t* xp = (const bf16_t*)xin + (size_t)(row0 + ai * 128 + m * 16) * D + col0;
#pragma unroll
                    for (int bj = 0; bj < 2; ++bj) xi[ai][m][bj] = *(const u32x4*)(xp + bj * 128); }
            asm volatile("" ::: "memory");
#pragma unroll
            for (int ai = 0; ai < 2; ++ai)
#pragma unroll
                for (int m = 0; m < 4; ++m) { bf16_t* op = xout + (size_t)(row0 + ai * 128 + m * 16) * D + col0;
#pragma unroll
                    for (int bj = 0; bj < 2; ++bj) { const unsigned* y = yp[ai][m][bj]; const u32x4 xw = xi[ai][m][bj];
                        u32x4 w; w.x = cvt_pk_bf16(bf_lo(xw.x) + bf_lo(y[0]), bf_hi(xw.x) + bf_hi(y[0])); w.y = cvt_pk_bf16(bf_lo(xw.y) + bf_lo(y[1]), bf_hi(xw.y) + bf_hi(y[1]));
                        w.z = cvt_pk_bf16(bf_lo(xw.z) + bf_lo(y[2]), bf_hi(xw.z) + bf_hi(y[2])); w.w = cvt_pk_bf16(bf_lo(xw.w) + bf_lo(y[3]), bf_hi(xw.w) + bf_hi(y[3]));
                        *(u32x4*)(op + bj * 128) = w; } }
        }
    }
};
struct EpiGateUp {
    static constexpr bool PERM = true, COLMAP64 = false;
    bf16_t* H;
    __device__ __forceinline__ void operator()(const f32x4 (&acc)[2][2][4][2], const pg8::Unit& u, int wr, int wc, int fr, int fq) const {
        const int row0 = u.pm * 256 + wr * 64 + fr, col0 = u.pn * 128 + wc * 32 + 8 * fq;
#pragma unroll
        for (int ai = 0; ai < 2; ++ai)
#pragma unroll
            for (int m = 0; m < 4; ++m) { bf16_t* rowp = H + (size_t)(row0 + ai * 128 + m * 16) * EFF + col0;
                f32x4 v0, v1;
#pragma unroll
                for (int j = 0; j < 4; ++j) { v0[j] = silu_f(acc[ai][0][m][0][j]) * acc[ai][1][m][0][j]; v1[j] = silu_f(acc[ai][0][m][1][j]) * acc[ai][1][m][1][j]; }
                u32x4 w; w.x = cvt_pk_bf16(v0[0], v0[1]); w.y = cvt_pk_bf16(v0[2], v0[3]); w.z = cvt_pk_bf16(v1[0], v1[1]); w.w = cvt_pk_bf16(v1[2], v1[3]);
                *(u32x4*)rowp = w; }
    }
};
struct EpiDown {
    static constexpr bool PERM = true, COLMAP64 = false;
    bf16_t* Y; const float* bw;
    __device__ __forceinline__ void operator()(const f32x4 (&acc)[2][2][4][2], const pg8::Unit& u, int wr, int wc, int fr, int fq) const {
        const int row0 = u.pm * 256 + wr * 64 + fr, col0 = u.pn * 256 + wc * 32 + 8 * fq;
        float sc[2][4];
#pragma unroll
        for (int ai = 0; ai < 2; ++ai)
#pragma unroll
            for (int m = 0; m < 4; ++m) sc[ai][m] = bw[row0 + ai * 128 + m * 16];
        asm volatile("" ::: "memory");
#pragma unroll
        for (int ai = 0; ai < 2; ++ai)
#pragma unroll
            for (int m = 0; m < 4; ++m) { const int row = row0 + ai * 128 + m * 16; bf16_t* rowp = Y + (size_t)row * D + col0;
#pragma unroll
                for (int bj = 0; bj < 2; ++bj) { const f32x4 v0 = acc[ai][bj][m][0] * sc[ai][m], v1 = acc[ai][bj][m][1] * sc[ai][m]; u32x4 w;
                    w.x = cvt_pk_bf16(v0[0], v0[1]); w.y = cvt_pk_bf16(v0[2], v0[3]); w.z = cvt_pk_bf16(v1[0], v1[1]); w.w = cvt_pk_bf16(v1[2], v1[3]);
                    *(u32x4*)(rowp + bj * 128) = w; } }
    }
};
struct MoeOrder {
    int G, c, ntn, nunits; const LAS int* tile_e;
    __device__ __forceinline__ bool next(int i, pg8::Unit& u) const {
        int tile, pn;
        if (G == 256) { const int x = c & 7, slot = c >> 3, tpb = 32 / ntn; tile = (i * 8 + x) * tpb + slot % tpb; pn = slot / tpb; if (tile * ntn >= nunits) return false; }
        else { const int Lu = i * G + c; if (Lu >= nunits) return false; tile = Lu / ntn; pn = Lu - tile * ntn; }
        u.pm = tile; u.pn = pn; u.pb = tile_e[tile] * ntn + pn; return true;
    }
};

struct TrItem { const float* src; bf16_t* dst; int ldn, ldk; };
#define TRANSPOSE_LOAD(it, tv) do { _Pragma("unroll") for (int _i = 0; _i < 32; ++_i) tv[_i] = __builtin_nontemporal_load((it).src + (size_t)(2 * _i + (lane >> 5)) * (it).ldn + (lane & 31)); } while (0)
#define TRANSPOSE_STORE(it, tv) do { \
    _Pragma("unroll") for (int _i = 0; _i < 32; ++_i) scr[(2 * _i + (lane >> 5)) * 33 + (lane & 31)] = tv[_i]; \
    LDS_WAIT(); asm volatile("" ::: "memory"); \
    { const int _c = lane & 7; \
      _Pragma("unroll") for (int _j = 0; _j < 4; ++_j) { const int _n = (lane >> 3) + 8 * _j; const LAS float* _sp = scr + (8 * _c) * 33 + _n; \
        u32x4 _o; _o.x = cvt_pk_bf16(_sp[0 * 33], _sp[1 * 33]); _o.y = cvt_pk_bf16(_sp[2 * 33], _sp[3 * 33]); _o.z = cvt_pk_bf16(_sp[4 * 33], _sp[5 * 33]); _o.w = cvt_pk_bf16(_sp[6 * 33], _sp[7 * 33]); \
        *(u32x4*)((it).dst + (size_t)_n * (it).ldk + 8 * _c) = _o; } } \
    LDS_WAIT(); asm volatile("" ::: "memory"); } while (0)
__device__ __forceinline__ TrItem prologue_item(const Params& p, int r) {
    unsigned char* ws = p.ws; TrItem it;
    constexpr int I_IN0 = 32 * 224, I_OUT = 32 * 64, I_IN1 = 32 * 192, I_EXP = 512, NDENSE = I_IN0 + I_OUT + I_IN1 + I_OUT;
    if (r < NDENSE) {
        if (r >= I_IN0 + I_OUT && r < I_IN0 + I_OUT + I_IN1) {
            r -= I_IN0 + I_OUT;
            const int nblk = 192, kb = r / nblk, nb = r % nblk, n0 = 32 * nb;
            const int row = n0 < 2048 ? 256 * (n0 >> 7) + (n0 & 127) : (n0 < 4096 ? 4096 + (n0 - 2048) : 256 * ((n0 - 4096) >> 7) + 128 + ((n0 - 4096) & 127));
            it.src = p.in[17] + (size_t)(64 * kb) * 6144 + n0; it.ldn = 6144; it.dst = (bf16_t*)(ws + WS_WIN1) + (size_t)row * 2048 + 64 * kb; it.ldk = 2048; return it;
        }
        const float* W; bf16_t* WT; int N;
        if (r < I_IN0) { W = p.in[9]; WT = (bf16_t*)(ws + WS_WIN0); N = 7168; }
        else if ((r -= I_IN0) < I_OUT) { W = p.in[10]; WT = (bf16_t*)(ws + WS_WOUT0); N = 2048; }
        else { r -= I_OUT + I_IN1; W = p.in[19]; WT = (bf16_t*)(ws + WS_WOUT1); N = 2048; }
        const int nblk = N / 32, kb = r / nblk, nb = r % nblk;
        it.src = W + (size_t)(64 * kb) * N + 32 * nb; it.ldn = N; it.dst = WT + (size_t)(32 * nb) * 2048 + 64 * kb; it.ldk = 2048; return it;
    }
    r -= NDENSE;
    const int le = r / (3 * I_EXP), rr = r % (3 * I_EXP), which = rr / I_EXP, item = rr % I_EXP;
    if (which < 2) {
        const int kb = item / 16, nb = item % 16, n0 = 32 * nb;
        it.src = (which ? p.in[25] : p.in[24]) + (size_t)le * 2048 * 512 + (size_t)(64 * kb) * 512 + n0; it.ldn = 512;
        it.dst = (bf16_t*)(ws + WS_EGU) + (size_t)le * 1024 * 2048 + (size_t)((n0 >> 7) * 256 + which * 128 + (n0 & 127)) * 2048 + 64 * kb; it.ldk = 2048;
    } else {
        const int kb = item / 64, nb = item % 64;
        it.src = p.in[26] + (size_t)le * 512 * 2048 + (size_t)(64 * kb) * 2048 + 32 * nb; it.ldn = 2048;
        it.dst = (bf16_t*)(ws + WS_EDN) + (size_t)le * 2048 * 512 + (size_t)(32 * nb) * 512 + 64 * kb; it.ldk = 512;
    }
    return it;
}
__device__ __forceinline__ void phase_prologue(const Params& p, LAS unsigned char* lds) {
    const int tid = threadIdx.x, lane = tid & 63, wave = __builtin_amdgcn_readfirstlane(tid >> 6);
    const int gw = blockIdx.x * NWAVES + wave, NGW = gridDim.x * NWAVES;
    unsigned char* ws = p.ws;
    LAS float* SL = (LAS float*)lds;
    for (int idx = tid; idx < 9 * 2048; idx += NTHREADS) { const int r = idx >> 11, k = idx & 2047; const float v = r < 8 ? p.in[1][r * 2048 + k] : p.in[3][k]; SL[idx] = silu_f(v); }
    __syncthreads();
    float* MP = (float*)(ws + WS_MP);
    for (int it = gw; it < 1536; it += NGW) {
        const int l = it / 768, rem = it % 768, cb = rem >> 4, ks = rem & 15;
        const int col0 = cb * 256 + lane * 4, k0 = ks * 128;
        const float* W = p.in[4] + (size_t)l * 2048 * 12288 + col0;
        f32x4 acc[9];
#pragma unroll
        for (int r = 0; r < 9; ++r) acc[r] = (f32x4){0.f, 0.f, 0.f, 0.f};
#pragma unroll 2
        for (int k = k0; k < k0 + 128; k += 4) {
            const f32x4 w0 = __builtin_nontemporal_load((const f32x4*)(W + (size_t)(k + 0) * 12288)), w1 = __builtin_nontemporal_load((const f32x4*)(W + (size_t)(k + 1) * 12288)),
                        w2 = __builtin_nontemporal_load((const f32x4*)(W + (size_t)(k + 2) * 12288)), w3 = __builtin_nontemporal_load((const f32x4*)(W + (size_t)(k + 3) * 12288));
#pragma unroll
            for (int r = 0; r < 9; ++r) { const f32x4 a = *(const LAS f32x4*)(SL + r * 2048 + k); acc[r] += a.x * w0 + a.y * w1 + a.z * w2 + a.w * w3; }
        }
#pragma unroll
        for (int r = 0; r < 9; ++r) *(f32x4*)(MP + ((size_t)((ks * 2 + l) * 9 + r)) * 12288 + col0) = acc[r];
    }
    __syncthreads();
    {
        _Float16* RW = (_Float16*)(ws + WS_RW); float* RB = (float*)(ws + WS_RB);
        for (int idx = blockIdx.x * NTHREADS + tid; idx < 2 * 48 * 2048; idx += gridDim.x * NTHREADS) {
            const int l = idx / (48 * 2048), rem = idx % (48 * 2048), col = rem >> 11, k = rem & 2047;
            float w = 0.f;
            if (col < 4) w = p.in[20][(size_t)l * 2048 * 4 + k * 4 + col]; else if (col < 36) w = p.in[22][(size_t)l * 2048 * 32 + k * 32 + (col - 4)];
            RW[idx] = (_Float16)w;
        }
        if (blockIdx.x == 0 && tid < 96) { const int l = tid / 48, col = tid % 48; float b = 0.f; if (col < 4) b = p.in[21][l * 4 + col]; else if (col < 36) b = p.in[23][l * 32 + col - 4]; RB[tid] = b; }
    }
    {
        LAS float* scr = (LAS float*)(lds + wave * 8704);
        constexpr int NITEMS = 32 * 224 + 32 * 64 + 32 * 192 + 32 * 64 + 64 * 3 * 512;
        const int n = gw < NITEMS ? (NITEMS - gw + NGW - 1) / NGW : 0;
        float tvA[32], tvB[32];
        TrItem iA = prologue_item(p, gw < NITEMS ? gw : NITEMS - 1), iB = iA; TRANSPOSE_LOAD(iA, tvA);
        int k = 0;
        for (; k + 2 < n; k += 2) {
            iB = prologue_item(p, gw + (k + 1) * NGW); TRANSPOSE_LOAD(iB, tvB); TRANSPOSE_STORE(iA, tvA);
            iA = prologue_item(p, gw + (k + 2) * NGW); TRANSPOSE_LOAD(iA, tvA); TRANSPOSE_STORE(iB, tvB);
        }
        { const int r1 = gw + (k + 1) * NGW; iB = prologue_item(p, r1 < NITEMS ? r1 : NITEMS - 1); TRANSPOSE_LOAD(iB, tvB); }
        if (k < n) TRANSPOSE_STORE(iA, tvA);
        if (k + 1 < n) TRANSPOSE_STORE(iB, tvB);
    }
}
__device__ __forceinline__ void phase_finalize(const Params& p) {
    unsigned char* ws = p.ws; const float* MP = (const float*)(ws + WS_MP); float* MOD = (float*)(ws + WS_MOD); float* LB = (float*)(ws + WS_LB);
    const int gt = blockIdx.x * NTHREADS + threadIdx.x, NT = gridDim.x * NTHREADS;
    for (int idx = gt; idx < 2 * 9 * 12288; idx += NT) {
        const int l = idx / (9 * 12288), rem = idx % (9 * 12288), r = rem / 12288, n = rem % 12288;
        float s = p.in[5][l * 12288 + n];
#pragma unroll
        for (int ks = 0; ks < 16; ++ks) s += MP[((size_t)((ks * 2 + l) * 9 + r)) * 12288 + n];
        MOD[idx] = s;
    }
    for (int idx = gt; idx < 2048; idx += NT) { const float r0 = p.in[11][idx], r1 = p.in[11][2048 + idx]; LB[idx] = 1.0f / (1.0f + __expf(r1 - r0)); }
}
__device__ __forceinline__ void norm_row_regs(f32x4 (&v)[8], const float* g, const float* sc, const float* sh, bf16_t* orow, int lane) {
    float s = 0.f;
#pragma unroll
    for (int j = 0; j < 8; ++j) s += (v[j].x * v[j].x + v[j].y * v[j].y) + (v[j].z * v[j].z + v[j].w * v[j].w);
    s = wave_sum(s);
    const float rinv = 1.0f / sqrtf(s * (1.0f / D) + EPS);
#pragma unroll
    for (int j = 0; j < 8; ++j) { const f32x4 gg = ((const f32x4*)g)[lane + 64 * j], cc = ((const f32x4*)sc)[lane + 64 * j], hh = ((const f32x4*)sh)[lane + 64 * j];
        const f32x4 h = v[j] * rinv * gg * (1.0f + cc) + hh;
        u32x2 w; w.x = cvt_pk_bf16(h.x, h.y); w.y = cvt_pk_bf16(h.z, h.w);
        ((u32x2*)orow)[lane + 64 * j] = w; }
}
__device__ __forceinline__ void phase_norm_mix0(const Params& p) {
    const int lane = threadIdx.x & 63, wave = __builtin_amdgcn_readfirstlane(threadIdx.x >> 6);
    const int gw = blockIdx.x * NWAVES + wave, NGW = gridDim.x * NWAVES;
    const float* MOD = (const float*)(p.ws + WS_MOD); bf16_t* HB = (bf16_t*)(p.ws + WS_HB);
    constexpr int NR = M + MC;
    const int n = gw < NR ? (NR - gw + NGW - 1) / NGW : 0;
#define NM_LOAD(v, r_) do { const int _r = (r_) < NR ? (r_) : NR - 1; const float* _x = _r < M ? p.in[0] + (size_t)_r * D : p.in[2] + (size_t)(_r - M) * D; \
        _Pragma("unroll") for (int j = 0; j < 8; ++j) v[j] = __builtin_nontemporal_load((const f32x4*)_x + lane + 64 * j); } while (0)
#define NM_STORE(v, r_) do { const int _r = (r_); const float* _md = MOD + (size_t)(_r < M ? _r / SEQ : 8) * 12288; norm_row_regs(v, p.in[6], _md + 2048, _md, HB + (size_t)_r * D, lane); } while (0)
    f32x4 va[8], vb[8];
    NM_LOAD(va, gw);
    int k = 0;
    for (; k + 2 < n; k += 2) {
        NM_LOAD(vb, gw + (k + 1) * NGW); NM_STORE(va, gw + k * NGW);
        NM_LOAD(va, gw + (k + 2) * NGW); NM_STORE(vb, gw + (k + 1) * NGW);
    }
    NM_LOAD(vb, gw + (k + 1) * NGW);
    if (k < n) NM_STORE(va, gw + k * NGW);
    if (k + 1 < n) NM_STORE(vb, gw + (k + 1) * NGW);
#undef NM_LOAD
#undef NM_STORE
}
__device__ __forceinline__ void phase_scan(const Params& p, LAS unsigned char* lds, int c) {
    const int tid = threadIdx.x, lane = tid & 63, w = __builtin_amdgcn_readfirstlane(tid >> 6), fr = lane & 15, fq = lane >> 4;
    const int b = c >> 5, h = (c >> 2) & 7, dir = (c >> 1) & 1, half = c & 1;
    unsigned char* ws = p.ws;
    const bf16_t* Q = (const bf16_t*)(ws + WS_Q);
    const _Float16* F = (const _Float16*)(ws + WS_Q + (size_t)(1 + dir) * PROJ_STRIDE);
    const bf16_t* V = (const bf16_t*)(ws + WS_Q + 3 * PROJ_STRIDE);
    const _Float16* CF = (const _Float16*)(ws + WS_CTXP + (size_t)dir * CTXP_STRIDE);
    const bf16_t* CV = (const bf16_t*)(ws + WS_CTXP + 2 * CTXP_STRIDE);
    bf16_t* O = (bf16_t*)(ws + (dir ? WS_OB : WS_OF));
    constexpr int QD_STRIDE = 272, KT_STRIDE = 144;
    constexpr int OFF_KET = 64 * QD_STRIDE, OFF_VT = OFF_KET + 128 * KT_STRIDE, OFF_PM = OFF_VT + 64 * KT_STRIDE, OFF_DEC = OFF_PM + 64 * KT_STRIDE, BUF_BYTES = OFF_DEC + 512;
    LAS unsigned char* KD = lds + 2 * BUF_BYTES;
    LAS float* TT = (LAS float*)(KD + 64 * QD_STRIDE);
    LAS unsigned char* QRAW = (LAS unsigned char*)(TT + 4 * 128);
    static_assert(2 * BUF_BYTES + 2 * 64 * QD_STRIDE + 4 * 128 * 4 <= MISC_OFF, "scan LDS");
#define SCAN_ROWBASE(t_, rb_, isctx_) const bool isctx_ = (t_) < 4; size_t rb_; { const int _n = isctx_ ? (t_) : (t_) - 4; const int _nch = isctx_ ? 4 : 64; const int _chn = dir ? _nch - 1 - _n : _n; \
        rb_ = (size_t)(b * 8 + h) * (isctx_ ? CL : SEQ) + (size_t)_chn * 64; }
    if (w >= 4) {
        const int pw = w - 4;
        const int k0 = 2 * lane; const int ppos = (k0 & ~31) + 8 * ((k0 >> 2) & 3) + 4 * ((k0 >> 4) & 1) + (k0 & 3);
        unsigned rfA[16], rfB[16], rfC[16];
#define SCAN_ISSUE_F(rf, t_) do { if ((t_) < 68) { SCAN_ROWBASE(t_, _rb, _isctx) \
        const unsigned* _pf = (const unsigned*)((_isctx ? CF : F) + (_rb + (dir ? 63 - 16 * pw : 16 * pw)) * 128 + k0); \
        if (dir) { _Pragma("unroll") for (int j = 0; j < 16; ++j) rf[j] = _pf[-64 * j]; } else { _Pragma("unroll") for (int j = 0; j < 16; ++j) rf[j] = _pf[64 * j]; } } } while (0)
#define SCAN_PRODUCE(rf, t_, ACT, ISSUE) do { const int t = (t_); constexpr bool act = (ACT); \
            LAS unsigned char* buf = lds + (t & 1) * BUF_BYTES; \
            if (act) { float a0 = 1.f, a1 = 1.f; \
                _Pragma("unroll") for (int j = 0; j < 16; ++j) { const unsigned wv = rf[j]; a0 *= (float)__builtin_bit_cast(_Float16, (unsigned short)(wv & 0xffffu)); a1 *= (float)__builtin_bit_cast(_Float16, (unsigned short)(wv >> 16)); } \
                *(LAS f32x2*)(TT + pw * 128 + k0) = (f32x2){a0, a1}; } \
            LDS_BARRIER();     \
            if (act) { \
                float eo0 = 1.f, eo1 = 1.f, el0 = 1.f, el1 = 1.f; \
                _Pragma("unroll") for (int ww = 0; ww < 4; ++ww) { const f32x2 tv = *(const LAS f32x2*)(TT + ww * 128 + k0); if (ww < pw) { eo0 *= tv.x; eo1 *= tv.y; } el0 *= tv.x; el1 *= tv.y; } \
                if (pw == 0) *(LAS f32x2*)(buf + OFF_DEC + 4 * k0) = (f32x2){el0, el1}; \
                unsigned ke[16]; \
                _Pragma("unroll") for (int j = 0; j < 16; ++j) { const int i = 16 * pw + j; \
                    const unsigned wv = rf[j]; const float f0 = (float)__builtin_bit_cast(_Float16, (unsigned short)(wv & 0xffffu)), f1 = (float)__builtin_bit_cast(_Float16, (unsigned short)(wv >> 16)); \
                    eo0 *= f0; eo1 *= f1; const float e0 = eo0, e1 = eo1; \
                    const float kd0 = (1.0f - f0) * __builtin_amdgcn_rcpf(e0), kd1 = (1.0f - f1) * __builtin_amdgcn_rcpf(e1); \
                    ke[j] = cvt_pk_bf16(kd0 * el0, kd1 * el1); \
                    const unsigned qw = *(const LAS unsigned*)(QRAW + i * QD_STRIDE + 2 * k0); \
                    *(LAS unsigned*)(buf + i * QD_STRIDE + 2 * ppos) = cvt_pk_bf16(bf_lo(qw) * e0, bf_hi(qw) * e1);     \
                    *(LAS unsigned*)(KD + i * QD_STRIDE + 2 * ppos) = cvt_pk_bf16(kd0, kd1); } \
                { u32x4 a, bb; \
                  _Pragma("unroll") for (int q = 0; q < 2; ++q) { \
                    a.x = (ke[8 * q + 0] & 0xffffu) | (ke[8 * q + 1] << 16); a.y = (ke[8 * q + 2] & 0xffffu) | (ke[8 * q + 3] << 16); a.z = (ke[8 * q + 4] & 0xffffu) | (ke[8 * q + 5] << 16); a.w = (ke[8 * q + 6] & 0xffffu) | (ke[8 * q + 7] << 16); \
                    bb.x = (ke[8 * q + 0] >> 16) | (ke[8 * q + 1] & 0xffff0000u); bb.y = (ke[8 * q + 2] >> 16) | (ke[8 * q + 3] & 0xffff0000u); bb.z = (ke[8 * q + 4] >> 16) | (ke[8 * q + 5] & 0xffff0000u); bb.w = (ke[8 * q + 6] >> 16) | (ke[8 * q + 7] & 0xffff0000u); \
                    *(LAS u32x4*)(buf + OFF_KET + (k0 + 0) * KT_STRIDE + 32 * pw + 16 * q) = a; *(LAS u32x4*)(buf + OFF_KET + (k0 + 1) * KT_STRIDE + 32 * pw + 16 * q) = bb; } } \
                if (ISSUE) SCAN_ISSUE_F(rf, t + 3); \
            } \
            LDS_BARRIER();     \
            LDS_BARRIER();     \
        } while (0)
        SCAN_ISSUE_F(rfA, 0); SCAN_ISSUE_F(rfB, 1); SCAN_ISSUE_F(rfC, 2);
        for (int t3 = 0; t3 < 63; t3 += 3) {
            SCAN_PRODUCE(rfA, t3, true, true);
            SCAN_PRODUCE(rfB, t3 + 1, true, true);
            SCAN_PRODUCE(rfC, t3 + 2, true, true);
        }
        SCAN_PRODUCE(rfA, 63, true, true); SCAN_PRODUCE(rfB, 64, true, true); SCAN_PRODUCE(rfC, 65, true, false);
        SCAN_PRODUCE(rfA, 66, true, false); SCAN_PRODUCE(rfB, 67, true, false); SCAN_PRODUCE(rfC, 68, false, false);
        SCAN_PRODUCE(rfA, 69, false, false); SCAN_PRODUCE(rfB, 70, false, false); SCAN_PRODUCE(rfC, 71, false, false);
#undef SCAN_PRODUCE
#undef SCAN_ISSUE_F
    } else {
        f32x4 S[8];
#pragma unroll
        for (int tk = 0; tk < 8; ++tk) S[tk] = (f32x4){0.f, 0.f, 0.f, 0.f};
        const int k0 = 2 * lane, vp = lane & 31, vh = lane >> 5, chv = 64 * half + 2 * vp;
        unsigned rqA[16], rvA[8], rqB[16], rvB[8];
#define SCAN_ISSUE_QV(rq, rv, t_) do { if ((t_) < 68) { SCAN_ROWBASE(t_, _rb, _isctx) \
        const unsigned* _pq = (const unsigned*)(Q + (_rb + (dir ? 63 - 16 * w : 16 * w)) * 128 + k0); \
        const unsigned* _pv = (const unsigned*)((_isctx ? CV : V) + (_rb + (dir ? 63 - 16 * w - 8 * vh : 16 * w + 8 * vh)) * 128 + chv); \
        if (dir) { _Pragma("unroll") for (int j = 0; j < 16; ++j) rq[j] = _pq[-64 * j]; _Pragma("unroll") for (int j = 0; j < 8; ++j) rv[j] = _pv[-64 * j]; } \
        else     { _Pragma("unroll") for (int j = 0; j < 16; ++j) rq[j] = _pq[64 * j];  _Pragma("unroll") for (int j = 0; j < 8; ++j) rv[j] = _pv[64 * j]; } } } while (0)
#define SCAN_CONSUME(rq, rv, s_, RUN, LAT, NXT, ISSUE, PNEXT) do { const int s = (s_); constexpr bool run = (RUN), lat = (LAT), nxt = (NXT); \
            LAS unsigned char* buf = lds + (s & 1) * BUF_BYTES; \
            LAS unsigned char* nbuf = lds + ((s + 1) & 1) * BUF_BYTES; \
              \
            bf16x8 qfa[4][4]; \
            if (lat) { \
                _Pragma("unroll") for (int tt = 0; tt < 4; ++tt) \
                    _Pragma("unroll") for (int g = 0; g < 4; ++g) qfa[tt][g] = *(const LAS bf16x8*)(buf + (16 * tt + fr) * QD_STRIDE + 2 * (32 * g + 8 * fq)); \
            } \
            if (nxt) {     \
                _Pragma("unroll") for (int j = 0; j < 16; ++j) *(LAS unsigned*)(QRAW + (16 * w + j) * QD_STRIDE + 2 * k0) = rq[j]; \
                u32x4 a, bb; \
                a.x = (rv[0] & 0xffffu) | (rv[1] << 16); a.y = (rv[2] & 0xffffu) | (rv[3] << 16); a.z = (rv[4] & 0xffffu) | (rv[5] << 16); a.w = (rv[6] & 0xffffu) | (rv[7] << 16); \
                bb.x = (rv[0] >> 16) | (rv[1] & 0xffff0000u); bb.y = (rv[2] >> 16) | (rv[3] & 0xffff0000u); bb.z = (rv[4] >> 16) | (rv[5] & 0xffff0000u); bb.w = (rv[6] >> 16) | (rv[7] & 0xffff0000u); \
                *(LAS u32x4*)(nbuf + OFF_VT + (2 * vp + 0) * KT_STRIDE + 32 * w + 16 * vh) = a; *(LAS u32x4*)(nbuf + OFF_VT + (2 * vp + 1) * KT_STRIDE + 32 * w + 16 * vh) = bb; \
                if (ISSUE) SCAN_ISSUE_QV(rq, rv, s + 3); } \
            f32x4 o[4]; \
            _Pragma("unroll") for (int tt = 0; tt < 4; ++tt) o[tt] = (f32x4){0.f, 0.f, 0.f, 0.f}; \
            if (lat) {     \
                bf16x8 sf[4]; \
                _Pragma("unroll") for (int g = 0; g < 4; ++g) { u32x4 t4; t4.x = cvt_pk_bf16(S[2 * g][0], S[2 * g][1]); t4.y = cvt_pk_bf16(S[2 * g][2], S[2 * g][3]); t4.z = cvt_pk_bf16(S[2 * g + 1][0], S[2 * g + 1][1]); t4.w = cvt_pk_bf16(S[2 * g + 1][2], S[2 * g + 1][3]); \
                    sf[g] = __builtin_bit_cast(bf16x8, t4); } \
                LDS_WAIT(); \
                _Pragma("unroll") for (int tt = 0; tt < 4; ++tt) \
                    _Pragma("unroll") for (int g = 0; g < 4; ++g) o[tt] = __builtin_amdgcn_mfma_f32_16x16x32_bf16(sf[g], qfa[tt][g], o[tt], 0, 0, 0); \
            } \
            LDS_BARRIER();     \
            bf16x8 vf[2], pfa[4][2], kfa[4][2], kfb[4][2]; f32x4 d4a[4], d4b[4]; \
            if (run) { _Pragma("unroll") for (int z = 0; z < 2; ++z) vf[z] = *(const LAS bf16x8*)(buf + OFF_VT + (16 * w + fr) * KT_STRIDE + 2 * (32 * z + 8 * fq)); } \
            if (lat) { _Pragma("unroll") for (int tt = 0; tt < 4; ++tt) _Pragma("unroll") for (int z = 0; z < 2; ++z) pfa[tt][z] = *(const LAS bf16x8*)(buf + OFF_PM + (16 * tt + fr) * KT_STRIDE + 2 * (32 * z + 8 * fq)); } \
            LDS_WAIT(); \
            if (run) {     \
                _Pragma("unroll") for (int tk = 0; tk < 4; ++tk) { d4a[tk] = *(const LAS f32x4*)(buf + OFF_DEC + 4 * (16 * tk + 4 * fq)); \
                    _Pragma("unroll") for (int z = 0; z < 2; ++z) kfa[tk][z] = *(const LAS bf16x8*)(buf + OFF_KET + (16 * tk + fr) * KT_STRIDE + 2 * (32 * z + 8 * fq)); } } \
            if (lat) {     \
                SCAN_ROWBASE(s, rb, isctx_unused) \
                (void)isctx_unused; \
                _Pragma("unroll") for (int tt = 0; tt < 4; ++tt) { \
                    _Pragma("unroll") for (int z = 0; z < 2; ++z) o[tt] = __builtin_amdgcn_mfma_f32_16x16x32_bf16(vf[z], pfa[tt][z], o[tt], 0, 0, 0); } \
                _Pragma("unroll") for (int tt = 0; tt < 4; ++tt) { \
                    const int i = 16 * tt + fr; const size_t row = rb + (dir ? 63 - i : i); \
                    u32x2 wv; wv.x = cvt_pk_bf16(o[tt][0], o[tt][1]); wv.y = cvt_pk_bf16(o[tt][2], o[tt][3]); \
                    *(u32x2*)(O + row * 128 + 64 * half + 16 * w + 4 * fq) = wv; } \
            } \
            if (run) {     \
                LDS_WAIT(); \
                _Pragma("unroll") for (int tk = 0; tk < 4; ++tk) { d4b[tk] = *(const LAS f32x4*)(buf + OFF_DEC + 4 * (16 * (tk + 4) + 4 * fq)); \
                    _Pragma("unroll") for (int z = 0; z < 2; ++z) kfb[tk][z] = *(const LAS bf16x8*)(buf + OFF_KET + (16 * (tk + 4) + fr) * KT_STRIDE + 2 * (32 * z + 8 * fq)); } \
                _Pragma("unroll") for (int tk = 0; tk < 4; ++tk) { \
                    f32x4 a = S[tk] * d4a[tk]; \
                    _Pragma("unroll") for (int z = 0; z < 2; ++z) a = __builtin_amdgcn_mfma_f32_16x16x32_bf16(kfa[tk][z], vf[z], a, 0, 0, 0); \
                    S[tk] = a; } \
                LDS_WAIT(); \
                _Pragma("unroll") for (int tk = 0; tk < 4; ++tk) { \
                    f32x4 a = S[tk + 4] * d4b[tk]; \
                    _Pragma("unroll") for (int z = 0; z < 2; ++z) a = __builtin_amdgcn_mfma_f32_16x16x32_bf16(kfb[tk][z], vf[z], a, 0, 0, 0); \
                    S[tk + 4] = a; } \
            } \
            LDS_BARRIER();     \
            if (PNEXT) {     \
                const int tt = w; \
                bf16x8 qf[4], kfp[4][4]; \
                _Pragma("unroll") for (int g = 0; g < 4; ++g) qf[g] = *(const LAS bf16x8*)(nbuf + (16 * tt + fr) * QD_STRIDE + 2 * (32 * g + 8 * fq)); \
                _Pragma("unroll") for (int ts = 0; ts < 4; ++ts) \
                    _Pragma("unroll") for (int g = 0; g < 4; ++g) kfp[ts][g] = *(const LAS bf16x8*)(KD + (16 * ts + fr) * QD_STRIDE + 2 * (32 * g + 8 * fq)); \
                LDS_WAIT(); \
                _Pragma("unroll") for (int ts = 0; ts < 4; ++ts) { \
                    const int ii = 16 * tt + fr, ip0 = 16 * ts + 4 * fq; \
                    u32x2 wv = (u32x2){0u, 0u}; \
                    if (ts <= tt) { \
                        f32x4 pc = (f32x4){0.f, 0.f, 0.f, 0.f}; \
                        _Pragma("unroll") for (int g = 0; g < 4; ++g) pc = __builtin_amdgcn_mfma_f32_16x16x32_bf16(kfp[ts][g], qf[g], pc, 0, 0, 0); \
                        f32x4 pm; \
                        _Pragma("unroll") for (int j = 0; j < 4; ++j) pm[j] = (ip0 + j <= ii) ? pc[j] : 0.f; \
                        wv.x = cvt_pk_bf16(pm[0], pm[1]); wv.y = cvt_pk_bf16(pm[2], pm[3]); } \
                    *(LAS u32x2*)(nbuf + OFF_PM + ii * KT_STRIDE + 2 * ip0) = wv; } \
            } \
            LDS_BARRIER();     \
        } while (0)
        SCAN_ISSUE_QV(rqA, rvA, 0); SCAN_ISSUE_QV(rqB, rvB, 1);
        SCAN_CONSUME(rqA, rvA, -1, false, false, true, true, false);
        SCAN_CONSUME(rqB, rvB, 0, true, false, true, true, false); SCAN_CONSUME(rqA, rvA, 1, true, false, true, true, false);
        SCAN_CONSUME(rqB, rvB, 2, true, false, true, true, false); SCAN_CONSUME(rqA, rvA, 3, true, false, true, true, true);
        for (int s2 = 4; s2 < 64; s2 += 2) {
            SCAN_CONSUME(rqB, rvB, s2, true, true, true, true, true);
            SCAN_CONSUME(rqA, rvA, s2 + 1, true, true, true, true, true);
        }
        SCAN_CONSUME(rqB, rvB, 64, true, true, true, true, true); SCAN_CONSUME(rqA, rvA, 65, true, true, true, false, true);
        SCAN_CONSUME(rqB, rvB, 66, true, true, true, false, true); SCAN_CONSUME(rqA, rvA, 67, true, true, false, false, false);
        SCAN_CONSUME(rqB, rvB, 68, false, false, false, false, false); SCAN_CONSUME(rqA, rvA, 69, false, false, false, false, false); SCAN_CONSUME(rqB, rvB, 70, false, false, false, false, false);
#undef SCAN_CONSUME
#undef SCAN_ISSUE_QV
    }
#undef SCAN_ROWBASE
}
__device__ __forceinline__ void phase_gmlp(const Params& p, LAS unsigned char* lds, int unit) {
    const int tid = threadIdx.x, lane = tid & 63, w = __builtin_amdgcn_readfirstlane(tid >> 6), fr = lane & 15, fq = lane >> 4;
    unsigned char* ws = p.ws;
    const bf16_t* U = (const bf16_t*)(ws + WS_Q + 5 * PROJ_STRIDE); const bf16_t* VG = (const bf16_t*)(ws + WS_Q + 6 * PROJ_STRIDE);
    bf16_t* A2 = (bf16_t*)(ws + WS_HB);
    const float* ln_g = p.in[13]; const float* ln_b = p.in[14]; const float* w_s = p.in[15]; const float* b_s = p.in[16];
    constexpr int TS = 272;
    LAS unsigned char* VNT = lds;
    LAS unsigned char* WS_ = lds + 128 * TS;
    LAS float* MU = (LAS float*)(lds + 2 * 128 * TS); LAS float* RS = MU + 128;
    const size_t row0 = (size_t)unit * 128;
    __syncthreads();
#pragma unroll
    for (int hf = 0; hf < 2; ++hf) {
        u32x4 xa[8][2];
#pragma unroll
        for (int rr = 0; rr < 8; ++rr) { const u32x4* src = (const u32x4*)(VG + (row0 + 16 * w + 8 * hf + rr) * 1024 + 16 * lane); xa[rr][0] = src[0]; xa[rr][1] = src[1]; }
        float sm[8], sq[8];
#pragma unroll
        for (int rr = 0; rr < 8; ++rr) { float s1 = 0.f, s2 = 0.f;
#pragma unroll
            for (int q = 0; q < 2; ++q) { const unsigned ww[4] = {xa[rr][q].x, xa[rr][q].y, xa[rr][q].z, xa[rr][q].w};
#pragma unroll
                for (int j = 0; j < 4; ++j) { const float a = bf_lo(ww[j]), c = bf_hi(ww[j]); s1 += a + c; s2 += a * a + c * c; } }
            sm[rr] = s1; sq[rr] = s2; }
#pragma unroll
        for (int o = 1; o < 64; o <<= 1) {
#pragma unroll
            for (int rr = 0; rr < 8; ++rr) { sm[rr] += __shfl_xor(sm[rr], o); sq[rr] += __shfl_xor(sq[rr], o); } }
        if (lane < 8) { float m = 0.f, q2 = 0.f;
#pragma unroll
            for (int rr = 0; rr < 8; ++rr) { m = (lane == rr) ? sm[rr] : m; q2 = (lane == rr) ? sq[rr] : q2; }
            const float mean = m * (1.0f / 1024.0f); const float var = fmaxf(q2 * (1.0f / 1024.0f) - mean * mean, 0.f);
            MU[16 * w + 8 * hf + lane] = mean; RS[16 * w + 8 * hf + lane] = 1.0f / sqrtf(var + EPS); }
    }
    unsigned vr[16]; f32x4 wr4[8];
#define GMLP_LOAD(g_) do { const int _d0 = 2 * lane; \
        _Pragma("unroll") for (int j = 0; j < 16; ++j) vr[j] = *(const unsigned*)(VG + (row0 + 16 * w + j) * 1024 + (g_) * 128 + _d0); \
        const f32x4* _src = (const f32x4*)(w_s + ((size_t)(g_) * 128 + (tid >> 2)) * 128 + (tid & 3) * 32); \
        _Pragma("unroll") for (int q4 = 0; q4 < 8; ++q4) wr4[q4] = _src[q4]; } while (0)
    GMLP_LOAD(0);
    __syncthreads();
#define GMLP_GROUP(g_, PREFETCH) do { const int g = (g_); \
        { const int d0 = 2 * lane; const float g0 = ln_g[g * 128 + d0], g1 = ln_g[g * 128 + d0 + 1], b0 = ln_b[g * 128 + d0], b1 = ln_b[g * 128 + d0 + 1]; \
          unsigned pk[16]; \
        _Pragma("unroll") \
          for (int j = 0; j < 16; ++j) { const int sidx = 16 * w + j; const unsigned wv = vr[j]; const float mu = MU[sidx], rs = RS[sidx]; \
              pk[j] = cvt_pk_bf16((bf_lo(wv) - mu) * rs * g0 + b0, (bf_hi(wv) - mu) * rs * g1 + b1); } \
          u32x4 a, bb, c2, d2; \
          a.x = (pk[0] & 0xffffu) | (pk[1] << 16); a.y = (pk[2] & 0xffffu) | (pk[3] << 16); a.z = (pk[4] & 0xffffu) | (pk[5] << 16); a.w = (pk[6] & 0xffffu) | (pk[7] << 16); \
          bb.x = (pk[8] & 0xffffu) | (pk[9] << 16); bb.y = (pk[10] & 0xffffu) | (pk[11] << 16); bb.z = (pk[12] & 0xffffu) | (pk[13] << 16); bb.w = (pk[14] & 0xffffu) | (pk[15] << 16); \
          c2.x = (pk[0] >> 16) | (pk[1] & 0xffff0000u); c2.y = (pk[2] >> 16) | (pk[3] & 0xffff0000u); c2.z = (pk[4] >> 16) | (pk[5] & 0xffff0000u); c2.w = (pk[6] >> 16) | (pk[7] & 0xffff0000u); \
          d2.x = (pk[8] >> 16) | (pk[9] & 0xffff0000u); d2.y = (pk[10] >> 16) | (pk[11] & 0xffff0000u); d2.z = (pk[12] >> 16) | (pk[13] & 0xffff0000u); d2.w = (pk[14] >> 16) | (pk[15] & 0xffff0000u); \
          *(LAS u32x4*)(VNT + (d0 + 0) * TS + 32 * w) = a; *(LAS u32x4*)(VNT + (d0 + 0) * TS + 32 * w + 16) = bb; \
          *(LAS u32x4*)(VNT + (d0 + 1) * TS + 32 * w) = c2; *(LAS u32x4*)(VNT + (d0 + 1) * TS + 32 * w + 16) = d2; } \
        { const int t = tid >> 2, s0 = (tid & 3) * 32; \
        _Pragma("unroll") \
          for (int q4 = 0; q4 < 4; ++q4) { const f32x4 x0 = wr4[2 * q4], x1 = wr4[2 * q4 + 1]; u32x4 o; o.x = cvt_pk_bf16(x0.x, x0.y); o.y = cvt_pk_bf16(x0.z, x0.w); o.z = cvt_pk_bf16(x1.x, x1.y); o.w = cvt_pk_bf16(x1.z, x1.w); \
              *(LAS u32x4*)(WS_ + t * TS + 2 * s0 + 16 * q4) = o; } } \
        u32x2 uv[8]; float bsv[8]; \
        _Pragma("unroll") \
        for (int tt = 0; tt < 8; ++tt) { const int t = 16 * tt + fr; uv[tt] = *(const u32x2*)(U + (row0 + t) * 1024 + g * 128 + 16 * w + 4 * fq); bsv[tt] = b_s[g * 128 + t]; } \
        if (PREFETCH) GMLP_LOAD(g + 1); \
        LDS_BARRIER(); \
        bf16x8 af[4]; \
        _Pragma("unroll") \
        for (int ks = 0; ks < 4; ++ks) af[ks] = *(const LAS bf16x8*)(VNT + (16 * w + fr) * TS + 2 * (32 * ks + 8 * fq)); \
        _Pragma("unroll") \
        for (int tt = 0; tt < 8; ++tt) { \
            f32x4 a = (f32x4){0.f, 0.f, 0.f, 0.f}; \
        _Pragma("unroll") \
            for (int ks = 0; ks < 4; ++ks) { const bf16x8 bfr = *(const LAS bf16x8*)(WS_ + (16 * tt + fr) * TS + 2 * (32 * ks + 8 * fq)); a = __builtin_amdgcn_mfma_f32_16x16x32_bf16(af[ks], bfr, a, 0, 0, 0); } \
            const int t = 16 * tt + fr; const float bs = bsv[tt]; \
            u32x2 o; o.x = cvt_pk_bf16(bf_lo(uv[tt].x) * (a[0] + bs), bf_hi(uv[tt].x) * (a[1] + bs)); o.y = cvt_pk_bf16(bf_lo(uv[tt].y) * (a[2] + bs), bf_hi(uv[tt].y) * (a[3] + bs)); \
            *(u32x2*)(A2 + (row0 + t) * 2048 + 1024 + g * 128 + 16 * w + 4 * fq) = o; \
        } \
        LDS_BARRIER(); \
    } while (0)
    for (int gg = 0; gg < 7; ++gg) GMLP_GROUP(gg, true);
    GMLP_GROUP(7, false);
#undef GMLP_GROUP
#undef GMLP_LOAD
}
__device__ __forceinline__ void phase_hgrn_out(const Params& p) {
    const int lane = threadIdx.x & 63, wave = __builtin_amdgcn_readfirstlane(threadIdx.x >> 6);
    const int gw = blockIdx.x * NWAVES + wave, NGW = gridDim.x * NWAVES;
    unsigned char* ws = p.ws;
    const bf16_t* OF = (const bf16_t*)(ws + WS_OF); const bf16_t* OB = (const bf16_t*)(ws + WS_OB); const bf16_t* G = (const bf16_t*)(ws + WS_Q + 4 * PROJ_STRIDE);
    bf16_t* A2 = (bf16_t*)(ws + WS_HB); const float* ng = p.in[12];
    f32x4 gn[4];
#pragma unroll
    for (int j = 0; j < 4; ++j) gn[j] = ((const f32x4*)(ng + 16 * lane))[j];
    const int n = gw < M ? (M - gw + NGW - 1) / NGW : 0;
    u32x4 fa[2], ba[2], ga[2], fb[2], bb[2], gb[2];
#define HO_LOAD(f_, b_, g_, r_) do { const int _r = (r_) < M ? (r_) : M - 1; \
        const size_t _ohm = ((size_t)((_r / SEQ) * 8 + (lane >> 3)) * SEQ + (_r % SEQ)) * 128 + 16 * (lane & 7);     \
        const u32x4* _pf = (const u32x4*)(OF + _ohm); const u32x4* _pb = (const u32x4*)(OB + _ohm); const u32x4* _pg = (const u32x4*)(G + (size_t)_r * 1024 + 16 * lane); \
        f_[0] = _pf[0]; f_[1] = _pf[1]; b_[0] = _pb[0]; b_[1] = _pb[1]; g_[0] = _pg[0]; g_[1] = _pg[1]; } while (0)
#define HO_STORE(f_, b_, g_, r_) do { const int r = (r_); float o[16]; float ss = 0.f; unsigned gg[8]; \
        _Pragma("unroll") for (int q = 0; q < 2; ++q) { const unsigned aw[4] = {f_[q].x, f_[q].y, f_[q].z, f_[q].w}, bw[4] = {b_[q].x, b_[q].y, b_[q].z, b_[q].w}, gw4[4] = {g_[q].x, g_[q].y, g_[q].z, g_[q].w}; \
            _Pragma("unroll") for (int j = 0; j < 4; ++j) { o[8 * q + 2 * j] = bf_lo(aw[j]) + bf_lo(bw[j]); o[8 * q + 2 * j + 1] = bf_hi(aw[j]) + bf_hi(bw[j]); gg[4 * q + j] = gw4[j]; } } \
        _Pragma("unroll") for (int j = 0; j < 16; ++j) ss += o[j] * o[j]; \
        ss += __shfl_xor(ss, 1); ss += __shfl_xor(ss, 2); ss += __shfl_xor(ss, 4); \
        const float rinv = 1.0f / sqrtf(ss * (1.0f / 128.0f) + EPS); \
        unsigned ow[8]; \
        _Pragma("unroll") for (int j = 0; j < 8; ++j) { const float g0 = gn[j >> 1][(2 * j) & 3], g1 = gn[j >> 1][(2 * j + 1) & 3]; \
            ow[j] = cvt_pk_bf16(o[2 * j] * rinv * g0 * bf_lo(gg[j]), o[2 * j + 1] * rinv * g1 * bf_hi(gg[j])); } \
        u32x4* dst = (u32x4*)(A2 + (size_t)r * 2048 + 16 * lane); \
        dst[0] = (u32x4){ow[0], ow[1], ow[2], ow[3]}; dst[1] = (u32x4){ow[4], ow[5], ow[6], ow[7]}; } while (0)
    HO_LOAD(fa, ba, ga, gw);
    int k = 0;
    for (; k + 2 < n; k += 2) {
        HO_LOAD(fb, bb, gb, gw + (k + 1) * NGW); HO_STORE(fa, ba, ga, gw + k * NGW);
        HO_LOAD(fa, ba, ga, gw + (k + 2) * NGW); HO_STORE(fb, bb, gb, gw + (k + 1) * NGW);
    }
    HO_LOAD(fb, bb, gb, gw + (k + 1) * NGW);
    if (k < n) HO_STORE(fa, ba, ga, gw + k * NGW);
    if (k + 1 < n) HO_STORE(fb, bb, gb, gw + (k + 1) * NGW);
#undef HO_LOAD
#undef HO_STORE
}
typedef _Float16 f16x8 __attribute__((ext_vector_type(8)));
typedef _Float16 f16x2 __attribute__((ext_vector_type(2)));
__device__ __forceinline__ unsigned cvt_pk_f16(float lo, float hi) { const f32x2 v = {lo, hi}; return __builtin_bit_cast(unsigned, __builtin_convertvector(v, f16x2)); }
__device__ __forceinline__ void phase_router(const Params& p, LAS unsigned char* lds, int l) {
    const int tid = threadIdx.x, lane = tid & 63, w = __builtin_amdgcn_readfirstlane(tid >> 6), fr = lane & 15, fq = lane >> 4;
    unsigned char* ws = p.ws;
    const bf16_t* X = (const bf16_t*)(ws + WS_XB); bf16_t* HB = (bf16_t*)(ws + WS_HB);
    const float* MOD = (const float*)(ws + WS_MOD) + (size_t)l * 9 * 12288;
    const _Float16* RW = (const _Float16*)(ws + WS_RW) + (size_t)l * 48 * 2048;
    const float* RB = (const float*)(ws + WS_RB) + l * 48; const float* gnorm = p.in[7] + (size_t)l * D;
    int* ASG_E = (int*)(ws + RT_ASG_E); int* ASG_R = (int*)(ws + RT_ASG_R); float* ASG_W = (float*)(ws + RT_ASG_W); int* CNT = (int*)(ws + RT_CNT);
    LAS float* GS = (LAS float*)lds;
    LAS float* SH = GS + 2048;
    LAS float* SSQ = SH + 2048;
    LAS float* PL = SSQ + 256;
    LAS float* LG = PL + 2 * 8 * 16 * 48;
    LAS int* T_E = (LAS int*)(LG + 128 * 48);
    LAS float* T_W = (LAS float*)(T_E + 256);
    LAS int* T_R = (LAS int*)(T_W + 256);
    f16x8 bw[8][3];
#pragma unroll
    for (int ks = 0; ks < 8; ++ks)
#pragma unroll
        for (int ct = 0; ct < 3; ++ct) bw[ks][ct] = *(const f16x8*)(RW + (size_t)(16 * ct + fr) * 2048 + 256 * w + 32 * ks + 8 * fq);
    for (int tile = blockIdx.x; tile < M / 128; tile += gridDim.x) {
        const int b = (tile * 128) / SEQ; const float* md = MOD + (size_t)b * 12288;
        __syncthreads();
        for (int k = tid; k < 2048; k += NTHREADS) { GS[k] = gnorm[k] * (1.0f + md[4 * 2048 + k]); SH[k] = md[3 * 2048 + k]; }
        u32x4 xw[8];
#define ROUTER_LOAD(grp_) do { const bf16_t* _src = X + ((size_t)tile * 128 + (grp_) * 16 + fr) * D + 256 * w + 8 * fq; \
        _Pragma("unroll") for (int ks = 0; ks < 8; ++ks) xw[ks] = *(const u32x4*)(_src + 32 * ks); } while (0)
        ROUTER_LOAD(0);
        __syncthreads();
#define ROUTER_GROUP(grp_, PREFETCH) do { const int grp = (grp_); \
            const size_t rbase = (size_t)tile * 128 + grp * 16; \
            LAS float* ssq = SSQ + (grp & 1) * 128; LAS float* pl = PL + (grp & 1) * (8 * 16 * 48); \
            float ss = 0.f; \
            _Pragma("unroll") \
            for (int ks = 0; ks < 8; ++ks) { const u32x4 t4 = xw[ks]; const unsigned tw[4] = {t4.x, t4.y, t4.z, t4.w}; \
            _Pragma("unroll") \
                for (int q = 0; q < 4; ++q) { const float a = bf_lo(tw[q]), c = bf_hi(tw[q]); ss += a * a + c * c; } } \
            ss += __shfl_xor(ss, 16); ss += __shfl_xor(ss, 32); \
            if (fq == 0) ssq[w * 16 + fr] = ss; \
            LDS_BARRIER(); \
            float tot = 0.f; \
            _Pragma("unroll") \
            for (int ww = 0; ww < 8; ++ww) tot += ssq[ww * 16 + fr]; \
            const float rinv = 1.0f / sqrtf(tot * (1.0f / D) + EPS); \
            f32x4 acc[3]; \
            _Pragma("unroll") \
            for (int ct = 0; ct < 3; ++ct) acc[ct] = (f32x4){0.f, 0.f, 0.f, 0.f}; \
            _Pragma("unroll") \
            for (int ks = 0; ks < 8; ++ks) { \
                const int kk = 256 * w + 32 * ks + 8 * fq; \
                float hv[8]; \
            _Pragma("unroll") \
                for (int q = 0; q < 2; ++q) { const f32x4 gs = *(const LAS f32x4*)(GS + kk + 4 * q), sh = *(const LAS f32x4*)(SH + kk + 4 * q); \
                    const unsigned x01 = q ? xw[ks].z : xw[ks].x, x23 = q ? xw[ks].w : xw[ks].y; const f32x4 xq = (f32x4){bf_lo(x01), bf_hi(x01), bf_lo(x23), bf_hi(x23)}; \
                    const f32x4 hh = xq * rinv * gs + sh; \
                    hv[4 * q] = hh.x; hv[4 * q + 1] = hh.y; hv[4 * q + 2] = hh.z; hv[4 * q + 3] = hh.w; } \
                u32x4 hi, hf; \
                hi.x = cvt_pk_bf16(hv[0], hv[1]); hi.y = cvt_pk_bf16(hv[2], hv[3]); hi.z = cvt_pk_bf16(hv[4], hv[5]); hi.w = cvt_pk_bf16(hv[6], hv[7]); \
                hf.x = cvt_pk_f16(hv[0], hv[1]); hf.y = cvt_pk_f16(hv[2], hv[3]); hf.z = cvt_pk_f16(hv[4], hv[5]); hf.w = cvt_pk_f16(hv[6], hv[7]); \
                *(u32x4*)(HB + (rbase + fr) * D + kk) = hi; \
                const f16x8 ah = __builtin_bit_cast(f16x8, hf); \
            _Pragma("unroll") \
                for (int ct = 0; ct < 3; ++ct) acc[ct] = __builtin_amdgcn_mfma_f32_16x16x32_f16(ah, bw[ks][ct], acc[ct], 0, 0, 0); \
                asm volatile("" ::: "memory"); \
            } \
            if (PREFETCH) ROUTER_LOAD(grp + 1);   \
            _Pragma("unroll") \
            for (int ct = 0; ct < 3; ++ct) \
            _Pragma("unroll") \
                for (int j = 0; j < 4; ++j) pl[(w * 16 + 4 * fq + j) * 48 + 16 * ct + fr] = acc[ct][j]; \
            LDS_BARRIER(); \
            for (int idx = tid; idx < 16 * 48; idx += NTHREADS) { float sred = 0.f; \
            _Pragma("unroll") \
                for (int ww = 0; ww < 8; ++ww) sred += pl[ww * 768 + idx]; \
                LG[grp * 768 + idx] = sred; } \
        } while (0)
        for (int gq = 0; gq < 7; ++gq) ROUTER_GROUP(gq, true);
        ROUTER_GROUP(7, false);
#undef ROUTER_GROUP
#undef ROUTER_LOAD
        __syncthreads();
        if (tid < 128) {
            float lg[4];
#pragma unroll
            for (int c2 = 0; c2 < 4; ++c2) lg[c2] = RB[c2] + LG[tid * 48 + c2];
            int gi = 0; float gm = lg[0];
#pragma unroll
            for (int q = 1; q < 4; ++q) if (lg[q] > gm) { gm = lg[q]; gi = q; }
            float gsum = 0.f;
#pragma unroll
            for (int q = 0; q < 4; ++q) gsum += __expf(lg[q] - gm);
            const float ptop = 1.0f / gsum;
            float le[8];
#pragma unroll
            for (int q = 0; q < 8; ++q) le[q] = RB[4 + 8 * gi + q] + LG[tid * 48 + 4 + 8 * gi + q];
            int i0 = 0; float m0 = le[0];
#pragma unroll
            for (int q = 1; q < 8; ++q) if (le[q] > m0) { m0 = le[q]; i0 = q; }
            int i1 = -1; float m1 = -3.0e38f;
#pragma unroll
            for (int q = 0; q < 8; ++q) if (q != i0 && le[q] > m1) { m1 = le[q]; i1 = q; }
            if (i1 < 0) { i1 = (i0 + 1) & 7; m1 = m0; }
            float e1 = __expf(m1 - m0);
            if (!(e1 <= 1.0f)) e1 = 1.0f;
            const float w0 = ptop / (1.0f + e1), w1 = ptop * e1 / (1.0f + e1);
            const int a0 = tid * 2;
            T_E[a0] = gi * 8 + i0; T_E[a0 + 1] = gi * 8 + i1; T_W[a0] = w0; T_W[a0 + 1] = w1;
        }
        __syncthreads();
        if (tid < 32) { int cnt = 0; for (int a = 0; a < 256; ++a) { if (T_E[a] == tid) { T_R[a] = cnt; ++cnt; } } CNT[tile * 32 + tid] = cnt; }
        __syncthreads();
        if (tid < 256) { ASG_E[tile * 256 + tid] = T_E[tid]; ASG_R[tile * 256 + tid] = T_R[tid]; ASG_W[tile * 256 + tid] = T_W[tid]; }
    }
}
__device__ __forceinline__ void moe_tables(const Params& p, LAS int* OFFS, LAS int* TOT, LAS int* TILE_E, LAS int* PART) {
    const int tid = threadIdx.x; const int* CNT = (const int*)(p.ws + RT_CNT); const int e = tid & 31, part = tid >> 5;
    int v[16];
#pragma unroll
    for (int j = 0; j < 16; ++j) v[j] = CNT[(part * 16 + j) * 32 + e];
    int sp = 0;
#pragma unroll
    for (int j = 0; j < 16; ++j) sp += v[j];
    PART[part * 32 + e] = sp;
    __syncthreads();
    if (tid < 32) { int t = 0;
#pragma unroll
        for (int q = 0; q < 16; ++q) t += PART[q * 32 + tid];
        TOT[tid] = t; }
    __syncthreads();
    if (tid == 0) { int o = 0; for (int ee = 0; ee < 32; ++ee) { OFFS[ee] = o; const int pad = (TOT[ee] + 255) & ~255; for (int t = o / 256; t < (o + pad) / 256; ++t) TILE_E[t] = ee; o += pad; } OFFS[32] = o; }
    __syncthreads();
}
__device__ __forceinline__ void phase_dispatch(const Params& p, LAS unsigned char* lds) {
    const int tid = threadIdx.x; unsigned char* ws = p.ws;
    const int* CNT = (const int*)(ws + RT_CNT); const int* ASG_E = (const int*)(ws + RT_ASG_E); const int* ASG_R = (const int*)(ws + RT_ASG_R); const float* ASG_W = (const float*)(ws + RT_ASG_W);
    int* POS = (int*)(ws + RT_POS); int* BUF_TOK = (int*)(ws + RT_BUF_TOK); float* BUF_W = (float*)(ws + RT_BUF_W);
    LAS int* OFFS = (LAS int*)lds; LAS int* TOT = OFFS + 64; LAS int* TILE_E = TOT + 64; LAS int* BASE = TILE_E + 320; LAS int* PART = BASE + 64;
    moe_tables(p, OFFS, TOT, TILE_E, PART);
    for (int tile = blockIdx.x; tile < M / 128; tile += gridDim.x) {
        __syncthreads();
        if (tid < 32) { const int qb = tile >> 4; int sb = OFFS[tid];
            for (int q = 0; q < qb; ++q) sb += PART[q * 32 + tid];
            int v[16];
#pragma unroll
            for (int j = 0; j < 16; ++j) v[j] = (16 * qb + j < tile) ? CNT[(16 * qb + j) * 32 + tid] : 0;
#pragma unroll
            for (int j = 0; j < 16; ++j) sb += v[j];
            BASE[tid] = sb; }
        __syncthreads();
        if (tid < 256) { const int a = tile * 256 + tid; const int e = ASG_E[a]; const int pos = BASE[e] + ASG_R[a]; POS[a] = pos; BUF_TOK[pos] = tile * 128 + (tid >> 1); BUF_W[pos] = ASG_W[a]; }
    }
    if (blockIdx.x < 32) { const int e = blockIdx.x; const int lo = OFFS[e] + TOT[e], hi = OFFS[e + 1]; for (int r = lo + tid; r < hi; r += NTHREADS) { BUF_TOK[r] = 0; BUF_W[r] = 0.f; } }
}
__device__ __forceinline__ void phase_moe_combine(const Params& p, LAS unsigned char* lds, int l, bool final_norm) {
    const int tid = threadIdx.x, lane = tid & 63, wave = __builtin_amdgcn_readfirstlane(tid >> 6);
    const int gw = blockIdx.x * NWAVES + wave, NGW = gridDim.x * NWAVES;
    unsigned char* ws = p.ws; bf16_t* XB = (bf16_t*)(ws + WS_XB); const bf16_t* Y = (const bf16_t*)(ws + WS_Y); const int* POS = (const int*)(ws + RT_POS);
    const float* MOD = (const float*)(ws + WS_MOD); bf16_t* HB = (bf16_t*)(ws + WS_HB);
    const int RPW = (M + NGW - 1) / NGW;
    const int rwg = blockIdx.x * NWAVES * RPW; const int b = (rwg < M ? rwg : 0) / SEQ;
    LAS float* GATE = (LAS float*)lds; LAS float* GS = GATE + 2048; LAS float* SH = GS + 2048;
    __syncthreads();
    for (int k = tid; k < 2048; k += NTHREADS) {
        GATE[k] = MOD[(size_t)(l * 9 + b) * 12288 + 5 * 2048 + k];
        if (!final_norm) { const float* md = MOD + (size_t)((l + 1) * 9 + b) * 12288; GS[k] = p.in[6][(size_t)(l + 1) * D + k] * (1.0f + md[2048 + k]); SH[k] = md[k]; }
        else { GS[k] = p.in[8][k]; SH[k] = 0.f; }
    }
    __syncthreads();
    const int r0 = gw * RPW; const int n = r0 < M ? ((M - r0) < RPW ? (M - r0) : RPW) : 0;
    u32x2 xa[8], ya0[8], ya1[8], xb[8], yb0[8], yb1[8];
#define MC_LOAD(xw, y0, y1, r_) do { const int _r = (r_) < M ? (r_) : M - 1; const int _p0 = POS[2 * _r], _p1 = POS[2 * _r + 1]; \
        const u32x2* _y0 = (const u32x2*)(Y + (size_t)_p0 * D); const u32x2* _y1 = (const u32x2*)(Y + (size_t)_p1 * D); const u32x2* _xr = (const u32x2*)(XB + (size_t)_r * D); \
        _Pragma("unroll") for (int j = 0; j < 8; ++j) { xw[j] = _xr[lane + 64 * j]; y0[j] = _y0[lane + 64 * j]; y1[j] = _y1[lane + 64 * j]; } } while (0)
#define MC_STORE(xw, y0, y1, r_) do { const int r = (r_); f32x4 v[8]; float sq = 0.f; \
        _Pragma("unroll") for (int j = 0; j < 8; ++j) { const u32x2 a = y0[j], c = y1[j]; f32x4 f; f.x = bf_lo(a.x) + bf_lo(c.x); f.y = bf_hi(a.x) + bf_hi(c.x); f.z = bf_lo(a.y) + bf_lo(c.y); f.w = bf_hi(a.y) + bf_hi(c.y); \
            const f32x4 x = (f32x4){bf_lo(xw[j].x), bf_hi(xw[j].x), bf_lo(xw[j].y), bf_hi(xw[j].y)}; v[j] = x + *(const LAS f32x4*)(GATE + 4 * (lane + 64 * j)) * f; } \
        if (!final_norm) { u32x2* xr = (u32x2*)(XB + (size_t)r * D); \
            _Pragma("unroll") for (int j = 0; j < 8; ++j) { u32x2 o; o.x = cvt_pk_bf16(v[j].x, v[j].y); o.y = cvt_pk_bf16(v[j].z, v[j].w); xr[lane + 64 * j] = o; \
                v[j] = (f32x4){bf_lo(o.x), bf_hi(o.x), bf_lo(o.y), bf_hi(o.y)}; } }     \
        _Pragma("unroll") for (int j = 0; j < 8; ++j) sq += (v[j].x * v[j].x + v[j].y * v[j].y) + (v[j].z * v[j].z + v[j].w * v[j].w); \
        sq = wave_sum(sq); const float rinv = 1.0f / sqrtf(sq * (1.0f / D) + EPS); \
        if (!final_norm) { \
            _Pragma("unroll") for (int j = 0; j < 8; ++j) { const f32x4 h = v[j] * rinv * *(const LAS f32x4*)(GS + 4 * (lane + 64 * j)) + *(const LAS f32x4*)(SH + 4 * (lane + 64 * j)); \
                u32x2 w2; w2.x = cvt_pk_bf16(h.x, h.y); w2.y = cvt_pk_bf16(h.z, h.w); ((u32x2*)(HB + (size_t)r * D))[lane + 64 * j] = w2; } \
        } else { \
            _Pragma("unroll") for (int j = 0; j < 8; ++j) ((f32x4*)(p.out + (size_t)r * D))[lane + 64 * j] = v[j] * rinv * *(const LAS f32x4*)(GS + 4 * (lane + 64 * j)); } } while (0)
    if (n > 0) {
        MC_LOAD(xa, ya0, ya1, r0);
        int k = 0;
        for (; k + 2 < n; k += 2) {
            MC_LOAD(xb, yb0, yb1, r0 + k + 1); MC_STORE(xa, ya0, ya1, r0 + k);
            MC_LOAD(xa, ya0, ya1, r0 + k + 2); MC_STORE(xb, yb0, yb1, r0 + k + 1);
        }
        MC_LOAD(xb, yb0, yb1, r0 + k + 1);
        if (k < n) MC_STORE(xa, ya0, ya1, r0 + k);
        if (k + 1 < n) MC_STORE(xb, yb0, yb1, r0 + k + 1);
    }
#undef MC_LOAD
#undef MC_STORE
}
__device__ __forceinline__ void phase_conv(const Params& p) {
    const int lane = threadIdx.x & 63, wave = __builtin_amdgcn_readfirstlane(threadIdx.x >> 6);
    const int gw = blockIdx.x * NWAVES + wave, NGW = gridDim.x * NWAVES;
    unsigned char* ws = p.ws; const bf16_t* Z = (const bf16_t*)(ws + WS_P1); const bf16_t* BG = (const bf16_t*)(ws + WS_P1 + P1_STRIDE);
    bf16_t* A2 = (bf16_t*)(ws + WS_HB); const float* cw = p.in[18];
    for (int it = gw; it < (M / 64) * 4; it += NGW) {
        const int grow = it >> 2, cb = it & 3; const int c0 = cb * 512 + lane * 8; const size_t r0 = (size_t)grow * 64;
        float w0[8], w1[8], w2[8];
#pragma unroll
        for (int j = 0; j < 8; ++j) { w0[j] = cw[c0 + j]; w1[j] = cw[2048 + c0 + j]; w2[j] = cw[4096 + c0 + j]; }
        float zp[8], zc[8];
#pragma unroll
        for (int j = 0; j < 8; ++j) zp[j] = 0.f;
        { const u32x4 z4 = *(const u32x4*)(Z + r0 * D + c0); const unsigned zw[4] = {z4.x, z4.y, z4.z, z4.w};
#pragma unroll
          for (int j = 0; j < 4; ++j) { zc[2 * j] = bf_lo(zw[j]); zc[2 * j + 1] = bf_hi(zw[j]); } }
        u32x4 zn = *(const u32x4*)(Z + (r0 + 1) * D + c0), bgc = *(const u32x4*)(BG + r0 * D + c0);
#pragma unroll 4
        for (int i = 0; i < 64; ++i) {
            const u32x4 znn = *(const u32x4*)(Z + (r0 + (i + 2 < 64 ? i + 2 : 63)) * D + c0), bgn = *(const u32x4*)(BG + (r0 + (i + 1 < 64 ? i + 1 : 63)) * D + c0);
            const unsigned zw[4] = {zn.x, zn.y, zn.z, zn.w}, bw[4] = {bgc.x, bgc.y, bgc.z, bgc.w};
            float znf[8];
#pragma unroll
            for (int j = 0; j < 4; ++j) { znf[2 * j] = (i < 63) ? bf_lo(zw[j]) : 0.f; znf[2 * j + 1] = (i < 63) ? bf_hi(zw[j]) : 0.f; }
            unsigned o[4];
#pragma unroll
            for (int j = 0; j < 4; ++j) { const float y0 = w0[2 * j] * zp[2 * j] + w1[2 * j] * zc[2 * j] + w2[2 * j] * znf[2 * j], y1 = w0[2 * j + 1] * zp[2 * j + 1] + w1[2 * j + 1] * zc[2 * j + 1] + w2[2 * j + 1] * znf[2 * j + 1];
                o[j] = cvt_pk_bf16(bf_lo(bw[j]) * y0, bf_hi(bw[j]) * y1); }
            *(u32x4*)(A2 + (r0 + i) * D + c0) = (u32x4){o[0], o[1], o[2], o[3]};
#pragma unroll
            for (int j = 0; j < 8; ++j) { zp[j] = zc[j]; zc[j] = znf[j]; }
            zn = znn; bgc = bgn;
        }
    }
}

constexpr int NPHASES = 20;
__global__ void __launch_bounds__(NTHREADS, 2) fwd_kernel(Params p) {
    extern __shared__ __attribute__((aligned(16))) unsigned char lds_raw[];
    LAS unsigned char* lds = (LAS unsigned char*)lds_raw;
    volatile LAS unsigned* MISC = (volatile LAS unsigned*)(lds + MISC_OFF);
    const int tid = threadIdx.x;
    for (int u = tid; u < (LDS_BYTES - MISC_OFF) / 4; u += NTHREADS) ((LAS unsigned*)(lds + MISC_OFF))[u] = 0u;
    __syncthreads();
    unsigned char* ws = p.ws;
    unsigned* barw = (unsigned*)(ws + WS_CTL) + CW_BAR;
    const bool multi = (p.ph_hi - p.ph_lo) > 1;
    XcdBarrier bar; bar.bar = barw; bar.x = 0; bar.st = nullptr;
    if (multi) bar = xcd_barrier_post(barw, MISC + 8);
    const int lo = p.ph_lo, hi = p.ph_hi;
#ifndef PH_MASK
#define PH_MASK 0xFFFFFu
#endif
#define IN(k) ((((PH_MASK) >> (k)) & 1u) && lo <= (k) && (k) < hi)
#define SEAM(k) do { if (IN(k) && IN((k) + 1)) xcd_barrier(bar); } while (0)
    const int G = gridDim.x, bx = blockIdx.x;
    LAS int* OFFS = (LAS int*)(lds + MISC_OFF + 64); LAS int* TOT = OFFS + 64; LAS int* TILE_E = TOT + 64;

    if (IN(0)) { phase_prologue(p, lds); } SEAM(0);
    if (IN(1)) { phase_finalize(p); } SEAM(1);
    if (IN(2)) { phase_norm_mix0(p); } SEAM(2);
    if (IN(3)) {
        pg8::Gemm g{(const bf16_t*)(ws + WS_HB), (const bf16_t*)(ws + WS_WIN0), D, nullptr};
        InProj0Order S; S.so.init(M, 7168, G, bx);
        EpiInProj0 E{ws, (const float*)(ws + WS_LB)};
        pg8::gemm_phase<EpiInProj0, InProj0Order, false>(lds, g, S, E);
    } SEAM(3);
    if (IN(4)) {
        for (int c = bx; c < 256; c += G) { __syncthreads(); phase_scan(p, lds, G == 256 ? (c & 7) * 32 + (c >> 3) : c); }
    } SEAM(4);
    if (IN(5)) {
        for (int u = bx; u < 256; u += G) phase_gmlp(p, lds, u);
        phase_hgrn_out(p);
    } SEAM(5);
    if (IN(6)) {
        pg8::Gemm g{(const bf16_t*)(ws + WS_HB), (const bf16_t*)(ws + WS_WOUT0), D, nullptr};
        pg8::StaticOrder S; S.init(M, D, G, bx);
        EpiResid<true> E{p.in[0], (bf16_t*)(ws + WS_XB), (const float*)(ws + WS_MOD) + 2 * 2048};
        pg8::gemm_phase<EpiResid<true>, pg8::StaticOrder, false>(lds, g, S, E);
    } SEAM(6);
#define MOE_BLOCK(l, pb) do { \
        if (IN(pb)) { phase_router(p, lds, l); } SEAM(pb); \
        if (IN((pb) + 1)) { phase_dispatch(p, lds); } SEAM((pb) + 1); \
        if (IN((pb) + 2)) { \
            __syncthreads(); moe_tables(p, OFFS, TOT, TILE_E, (LAS int*)lds); \
            pg8::Gemm g{(const bf16_t*)(ws + WS_HB), (const bf16_t*)(ws + WS_EGU) + (size_t)(l) * 32 * 1024 * 2048, D, (const int*)(ws + RT_BUF_TOK)}; \
            MoeOrder S{G, bx, 4, (OFFS[32] / 256) * 4, TILE_E}; \
            EpiGateUp E{(bf16_t*)(ws + WS_HMID)}; \
            pg8::gemm_phase<EpiGateUp, MoeOrder, true>(lds, g, S, E); \
        } SEAM((pb) + 2); \
        if (IN((pb) + 3)) { \
            __syncthreads(); moe_tables(p, OFFS, TOT, TILE_E, (LAS int*)lds); \
            pg8::Gemm g{(const bf16_t*)(ws + WS_HMID), (const bf16_t*)(ws + WS_EDN) + (size_t)(l) * 32 * 2048 * 512, EFF, nullptr}; \
            MoeOrder S{G, bx, 8, (OFFS[32] / 256) * 8, TILE_E}; \
            EpiDown E{(bf16_t*)(ws + WS_Y), (const float*)(ws + RT_BUF_W)}; \
            pg8::gemm_phase<EpiDown, MoeOrder, false>(lds, g, S, E); \
        } SEAM((pb) + 3); \
        if (IN((pb) + 4)) { phase_moe_combine(p, lds, l, (l) == 1); } SEAM((pb) + 4); \
    } while (0)
    MOE_BLOCK(0, 7);
    if (IN(12)) {
        pg8::Gemm g{(const bf16_t*)(ws + WS_HB), (const bf16_t*)(ws + WS_WIN1), D, nullptr};
        pg8::StaticOrder S; S.init(M, 6144, G, bx);
        EpiOddIn E{(bf16_t*)(ws + WS_P1), (bf16_t*)(ws + WS_P1 + P1_STRIDE)};
        pg8::gemm_phase<EpiOddIn, pg8::StaticOrder, false>(lds, g, S, E);
    } SEAM(12);
    if (IN(13)) { phase_conv(p); } SEAM(13);
    if (IN(14)) {
        pg8::Gemm g{(const bf16_t*)(ws + WS_HB), (const bf16_t*)(ws + WS_WOUT1), D, nullptr};
        pg8::StaticOrder S; S.init(M, D, G, bx);
        EpiResid<false> E{ws + WS_XB, (bf16_t*)(ws + WS_XB), (const float*)(ws + WS_MOD) + 9 * 12288 + 2 * 2048};
        pg8::gemm_phase<EpiResid<false>, pg8::StaticOrder, false>(lds, g, S, E);
    } SEAM(14);
    MOE_BLOCK(1, 15);
#undef MOE_BLOCK
#undef IN
#undef SEAM
}

extern "C" void kernel_launch(void* const* d_in, const int* in_sizes, int n_in, void* d_out, int out_size, void* d_ws, size_t ws_size, hipStream_t stream) {
    static int grid = 0;
    if (grid == 0) {
        if (n_in != 27 || out_size != M * D || ws_size < WS_END) { fprintf(stderr, "kernel_launch: unexpected shapes: n_in %d out %d ws %zu (need %zu)\n", n_in, out_size, ws_size, (size_t)WS_END); grid = -1; return; }
        int dev = 0, cus = 0, per_cu = 0;
        if (hipGetDevice(&dev) != hipSuccess || hipDeviceGetAttribute(&cus, hipDeviceAttributeMultiprocessorCount, dev) != hipSuccess) { grid = -1; return; }
        if (hipFuncSetAttribute((const void*)fwd_kernel, hipFuncAttributeMaxDynamicSharedMemorySize, LDS_BYTES) != hipSuccess) { fprintf(stderr, "kernel_launch: hipFuncSetAttribute failed\n"); grid = -1; return; }
        if (hipOccupancyMaxActiveBlocksPerMultiprocessor(&per_cu, (const void*)fwd_kernel, NTHREADS, LDS_BYTES) != hipSuccess || per_cu < 1)
            fprintf(stderr, "kernel_launch: occupancy query reports %d workgroups per CU\n", per_cu);
        (void)hipGetLastError();
        grid = cus;
    }
    if (grid < 0) return;
    (void)hipMemsetAsync((char*)d_ws + WS_CTL, 0, CTL_ZERO_BYTES, stream);
    Params p{};
    for (int i = 0; i < 27; ++i) p.in[i] = (const float*)d_in[i];
    p.out = (float*)d_out; p.ws = (unsigned char*)d_ws;
#if MK_ONE_LAUNCH
    p.ph_lo = 0; p.ph_hi = NPHASES;
    hipLaunchKernelGGL(fwd_kernel, dim3(grid), dim3(NTHREADS), LDS_BYTES, stream, p);
#else
#ifndef MAX_PHASE
#define MAX_PHASE NPHASES
#endif
    for (int ph = 0; ph < MAX_PHASE; ++ph) { p.ph_lo = ph; p.ph_hi = ph + 1; hipLaunchKernelGGL(fwd_kernel, dim3(grid), dim3(NTHREADS), LDS_BYTES, stream, p); }
#endif
}
```
